# Optimizing an MI355X kernel written in HIP

```python
import jax, jax.numpy as jnp
from jax import lax
import numpy as np

D_MODEL = 1024
BATCH = 8
SEQ = 4096
DEPTH = 4

CONV_WIDTH = 3
CONV_DIM = D_MODEL
CONV_GROUPS = 8
SGU_DIM = D_MODEL
SGU_HEADS = 8
SGU_HEAD_DIM = SGU_DIM // SGU_HEADS
CHUNK = 128
N_BRANCHES = 2
D_FF = 4 * D_MODEL
IN_COLS = 3 * CONV_DIM + 2 * SGU_DIM + N_BRANCHES * D_MODEL
EPS = 1e-6

kernel_name = "hybrid_shortconv_chunked_sgu_block"

SPLIT_POINTS = [
    CONV_DIM,
    2 * CONV_DIM,
    3 * CONV_DIM,
    3 * CONV_DIM + SGU_DIM,
    3 * CONV_DIM + 2 * SGU_DIM,
    3 * CONV_DIM + 2 * SGU_DIM + D_MODEL,
]


def rms_norm(x, g):
    xf = x.astype(jnp.float32)
    y = xf * lax.rsqrt(jnp.mean(xf * xf, axis=-1, keepdims=True) + EPS)
    return (y * g.astype(jnp.float32)).astype(x.dtype)


def layer_norm(x, g, b):
    xf = x.astype(jnp.float32)
    mu = jnp.mean(xf, axis=-1, keepdims=True)
    xc = xf - mu
    var = jnp.mean(xc * xc, axis=-1, keepdims=True)
    y = xc * lax.rsqrt(var + EPS) * g.astype(jnp.float32) + b.astype(jnp.float32)
    return y.astype(x.dtype)


def causal_depthwise_conv(z, w):
    seq = z.shape[1]
    zp = jnp.pad(z, ((0, 0), (CONV_WIDTH - 1, 0), (0, 0)))
    y = w[0] * zp[:, 0:seq]
    for k in range(1, CONV_WIDTH):
        y = y + w[k] * zp[:, k:k + seq]
    return y


def chunked_spatial_gating(u, v, w_s, b_s, ln_g, ln_b):
    bsz, seq, _ = v.shape
    n_chunks = seq // CHUNK
    vn = layer_norm(v, ln_g, ln_b).reshape(bsz, n_chunks, CHUNK, SGU_HEADS, SGU_HEAD_DIM)
    causal_mask = jnp.tril(jnp.ones((CHUNK, CHUNK), dtype=w_s.dtype))
    mixed = jnp.einsum('hts,bnshd->bnthd', w_s * causal_mask, vn)
    mixed = mixed + jnp.transpose(b_s)[None, None, :, :, None]
    return u * mixed.reshape(bsz, seq, SGU_DIM)


def setup_inputs(seed: int = 0) -> dict:
    key = jax.random.key(seed)
    ks = jax.random.split(key, 14)
    f32 = jnp.float32
    x = jax.random.normal(ks[0], (BATCH, SEQ, D_MODEL), f32)
    norm_mix = 1.0 + 0.02 * jax.random.normal(ks[1], (DEPTH, D_MODEL), f32)
    w_in = jax.random.normal(ks[2], (DEPTH, D_MODEL, IN_COLS), f32) * D_MODEL ** -0.5
    conv_w = jax.random.normal(ks[3], (DEPTH, CONV_WIDTH, CONV_DIM), f32) * CONV_WIDTH ** -0.5
    sgu_w = jax.random.normal(ks[4], (DEPTH, SGU_HEADS, CHUNK, CHUNK), f32) * CHUNK ** -0.5
    sgu_b = 1.0 + 0.02 * jax.random.normal(ks[5], (DEPTH, SGU_HEADS, CHUNK), f32)
    sgu_ln_g = 1.0 + 0.02 * jax.random.normal(ks[6], (DEPTH, SGU_DIM), f32)
    sgu_ln_b = 0.02 * jax.random.normal(ks[7], (DEPTH, SGU_DIM), f32)
    w_out = jax.random.normal(ks[8], (DEPTH, D_MODEL, D_MODEL), f32) * D_MODEL ** -0.5
    norm_mlp = 1.0 + 0.02 * jax.random.normal(ks[9], (DEPTH, D_MODEL), f32)
    w_ff1 = jax.random.normal(ks[10], (DEPTH, D_MODEL, D_FF), f32) * D_MODEL ** -0.5
    w_ff2 = jax.random.normal(ks[11], (DEPTH, D_FF, D_MODEL), f32) * D_FF ** -0.5
    final_norm = 1.0 + 0.02 * jax.random.normal(ks[12], (D_MODEL,), f32)
    return {
        "x": x, "norm_mix": norm_mix, "w_in": w_in, "conv_w": conv_w,
        "sgu_w": sgu_w, "sgu_b": sgu_b, "sgu_ln_g": sgu_ln_g, "sgu_ln_b": sgu_ln_b,
        "w_out": w_out, "norm_mlp": norm_mlp, "w_ff1": w_ff1, "w_ff2": w_ff2,
        "final_norm": final_norm,
    }


def reference(x, norm_mix, w_in, conv_w, sgu_w, sgu_b, sgu_ln_g, sgu_ln_b,
              w_out, norm_mlp, w_ff1, w_ff2, final_norm):
    for l in range(DEPTH):
        h = rms_norm(x, norm_mix[l])
        proj = jnp.einsum('bsd,dc->bsc', h, w_in[l])
        c_gate, b_gate, a_in, u, v, g_a, g_b = jnp.split(proj, SPLIT_POINTS, axis=-1)
        y_a = b_gate * causal_depthwise_conv(c_gate * a_in, conv_w[l])
        y_b = chunked_spatial_gating(jax.nn.gelu(u), jax.nn.gelu(v), sgu_w[l], sgu_b[l],
                                     sgu_ln_g[l], sgu_ln_b[l])
        merged = jax.nn.sigmoid(g_a) * y_a + jax.nn.sigmoid(g_b) * y_b
        x = x + jnp.einsum('bsd,de->bse', merged, w_out[l])
        h = rms_norm(x, norm_mlp[l])
        hid = jnp.square(jax.nn.relu(jnp.einsum('bsd,df->bsf', h, w_ff1[l])))
        x = x + jnp.einsum('bsf,fd->bsd', hid, w_ff2[l])
    return rms_norm(x, final_norm)
```

```cpp
#include <hip/hip_runtime.h>
#include <hip/hip_cooperative_groups.h>
#include <cstdio>
#include <cstdint>
namespace cg = cooperative_groups;
namespace pg8 {
#define PG8_LAS __attribute__((address_space(3)))
typedef unsigned short bf16_t;
typedef short bf16x8 __attribute__((ext_vector_type(8)));
typedef float f32x4 __attribute__((ext_vector_type(4)));
typedef unsigned u32x4 __attribute__((ext_vector_type(4)));
constexpr int BM = 256, BK = 64, HALF = 128, HTB = HALF * BK * 2  , STAGE_BYTES = 8 * HTB, NXCD = 8, WGM = 8;

__host__ __device__ __forceinline__ int lds_byte(int r, int c) { const int st = (r >> 4) * 2 + (c >> 5), rr = r & 15, cc = c & 31, ob = rr * 64 + cc * 2; return st * 1024 + (ob ^ (((ob >> 9) & 1) << 5)); }
__host__ __device__ __forceinline__ void stage_rc(int b, int& R, int& C) { const int st = b / 1024, sb = b % 1024, swz = sb ^ (((sb >> 9) & 1) << 5); R = (st >> 1) * 16 + swz / 64; C = (st & 1) * 32 + (swz % 64) / 2; }
__host__ __device__ __forceinline__ int perm32(int rho) { const int n = rho >> 4, i = rho & 15; return 8 * (i >> 2) + 4 * n + (i & 3); }

struct Unit { int pm, pn; };
struct Gemm { const bf16_t* A; const bf16_t* Bt; int M, N, K; };

struct StaticOrder {
    int nM, nN, nwg, G, c;
    __host__ __device__ void init(int M, int N, int G_, int c_) { nM = M / BM; nN = N / BM; nwg = nM * nN; G = G_; c = c_; }
    __host__ __device__ bool next(int i, Unit& u) const {
        const long L = (long)i * G + c; if (L >= nwg) return false;
        int wgid = (int)L; { const int q = nwg / NXCD, r = nwg % NXCD, xcd = wgid % NXCD, off = wgid / NXCD; wgid = (xcd < r ? xcd * (q + 1) : r * (q + 1) + (xcd - r) * q) + off; }
        const int nig = WGM * nN, gid = wgid / nig, fm = gid * WGM, gsz = (nM - fm) < WGM ? (nM - fm) : WGM;
        u.pm = fm + ((wgid % nig) % gsz); u.pn = (wgid % nig) / gsz; return true;
    }
    __device__ __forceinline__ void a_ready(const Unit&) const {}
    __device__ __forceinline__ void done(const Unit&) const {}
};

struct GemmL { const bf16_t* A; const bf16_t* Bt; int M, N, K, lda; };
__device__ __forceinline__ unsigned cvt_pk_bf16(float lo, float hi) { unsigned r; asm volatile("v_cvt_pk_bf16_f32 %0, %1, %2" : "=v"(r) : "v"(lo), "v"(hi)); return r; }
__device__ __forceinline__ float bf_lo(unsigned w) { return __uint_as_float(w << 16); }
__device__ __forceinline__ float bf_hi(unsigned w) { return __uint_as_float(w & 0xffff0000u); }
__device__ __forceinline__ float sigm(float x) { return __builtin_amdgcn_rcpf(1.f + __builtin_amdgcn_exp2f(-1.4426950408889634f * x)); }
__device__ __forceinline__ float gelu_t(float x) { const float u = x * (1.5957691216057308f + 0.0713548162726f * x * x); return x * __builtin_amdgcn_rcpf(1.f + __builtin_amdgcn_exp2f(-1.4426950408889634f * u)); }
__device__ __forceinline__ f32x4 sigm4(f32x4 v) { return (f32x4){sigm(v[0]), sigm(v[1]), sigm(v[2]), sigm(v[3])}; }
__device__ __forceinline__ f32x4 gelu4(f32x4 v) { return (f32x4){gelu_t(v[0]), gelu_t(v[1]), gelu_t(v[2]), gelu_t(v[3])}; }
__device__ __forceinline__ u32x4 pack8(f32x4 a, f32x4 b) { u32x4 w; w.x = cvt_pk_bf16(a[0], a[1]); w.y = cvt_pk_bf16(a[2], a[3]); w.z = cvt_pk_bf16(b[0], b[1]); w.w = cvt_pk_bf16(b[2], b[3]); return w; }
__device__ __forceinline__ float hsum4(f32x4 a) { return (a[0] + a[1]) + (a[2] + a[3]); }
constexpr float EPS = 1e-6f;
constexpr int DM = 1024, PW = 4096;
__device__ __forceinline__ float row_rstd(const float* ssx, int row, int fq) {
    const f32x4 p = *(const f32x4*)(ssx + (size_t)row * 16 + 4 * fq);
    float s = hsum4(p); s += __shfl_xor(s, 16); s += __shfl_xor(s, 32);
    return rsqrtf(s * (1.0f / DM) + EPS);
}
struct EpiIn {
    static constexpr int PERM = 2; static constexpr bool AFTER_DRAIN = false;
    bf16_t* P; const float* ssx; float* lnp;
    __device__ __forceinline__ void operator()(const f32x4 (&acc)[2][2][4][2], const Unit& u, int wr, int wc, int fr, int fq) const {
        const int row0 = u.pm * BM + wr * 64 + fr, type = u.pn >> 3, j = u.pn & 7, cb = wc * 32 + 8 * fq;
#pragma unroll
        for (int ai = 0; ai < 2; ++ai)
#pragma unroll
            for (int m = 0; m < 4; ++m) {
                const int row = row0 + ai * HALF + m * 16; const float rs = row_rstd(ssx, row, fq);
                const f32x4 x0 = acc[ai][0][m][0] * rs, x1 = acc[ai][0][m][1] * rs, y0 = acc[ai][1][m][0] * rs, y1 = acc[ai][1][m][1] * rs;
                bf16_t* rp = P + (size_t)row * PW;
                if (type == 3) {
                    const f32x4 a0 = gelu4(x0), a1 = gelu4(x1), b0 = gelu4(y0), b1 = gelu4(y1);
                    float s = (hsum4(a0) + hsum4(a1)) + (hsum4(b0) + hsum4(b1));
                    float q = (hsum4(a0 * a0) + hsum4(a1 * a1)) + (hsum4(b0 * b0) + hsum4(b1 * b1));
                    s += __shfl_xor(s, 16); s += __shfl_xor(s, 32); q += __shfl_xor(q, 16); q += __shfl_xor(q, 32);
                    *(u32x4*)(rp + 3072 + 256 * j + 2 * cb) = pack8(a0, a1); *(u32x4*)(rp + 3072 + 256 * j + 2 * cb + 8) = pack8(b0, b1);
                    if (fq == 0) { float* lp = lnp + ((size_t)row * 16 + j * 4 + wc) * 2; lp[0] = s; lp[1] = q; }
                } else {
                    f32x4 o0, o1;
                    if (type == 0) { o0 = x0 * y0; o1 = x1 * y1; }
                    else if (type == 1) { o0 = x0 * sigm4(y0); o1 = x1 * sigm4(y1); }
                    else { o0 = gelu4(x0) * sigm4(y0); o1 = gelu4(x1) * sigm4(y1); }
                    *(u32x4*)(rp + type * 1024 + 128 * j + cb) = pack8(o0, o1);
                }
            }
    }
};
struct EpiRes {
    static constexpr int PERM = 2; static constexpr bool AFTER_DRAIN = false;
    bf16_t* X; float* ssx;
    __device__ __forceinline__ void operator()(const f32x4 (&acc)[2][2][4][2], const Unit& u, int wr, int wc, int fr, int fq) const {
        const int row0 = u.pm * BM + wr * 64 + fr, col0 = u.pn * BM + wc * 64 + 16 * fq;
#pragma unroll
        for (int ai = 0; ai < 2; ++ai)
#pragma unroll
            for (int m = 0; m < 4; ++m) {
                const int row = row0 + ai * HALF + m * 16; float q = 0.f;
#pragma unroll
                for (int bj = 0; bj < 2; ++bj) {
                    bf16_t* p = X + (size_t)row * DM + col0 + bj * 8; const u32x4 o = *(const u32x4*)p;
                    const f32x4 v0 = acc[ai][bj][m][0] + (f32x4){bf_lo(o.x), bf_hi(o.x), bf_lo(o.y), bf_hi(o.y)};
                    const f32x4 v1 = acc[ai][bj][m][1] + (f32x4){bf_lo(o.z), bf_hi(o.z), bf_lo(o.w), bf_hi(o.w)};
                    q += hsum4(v0 * v0) + hsum4(v1 * v1);
                    *(u32x4*)p = pack8(v0, v1);
                }
                q += __shfl_xor(q, 16); q += __shfl_xor(q, 32);
                if (fq == 0) ssx[(size_t)row * 16 + u.pn * 4 + wc] = q;
            }
    }
};
struct EpiFF1 {
    static constexpr int PERM = 2; static constexpr bool AFTER_DRAIN = false;
    bf16_t* H; const float* ssx;
    __device__ __forceinline__ void operator()(const f32x4 (&acc)[2][2][4][2], const Unit& u, int wr, int wc, int fr, int fq) const {
        const int row0 = u.pm * BM + wr * 64 + fr, col0 = u.pn * BM + wc * 64 + 16 * fq;
#pragma unroll
        for (int ai = 0; ai < 2; ++ai)
#pragma unroll
            for (int m = 0; m < 4; ++m) {
                const int row = row0 + ai * HALF + m * 16; const float rs = row_rstd(ssx, row, fq);
#pragma unroll
                for (int bj = 0; bj < 2; ++bj) {
                    f32x4 v0 = acc[ai][bj][m][0] * rs, v1 = acc[ai][bj][m][1] * rs;
                    v0 = __builtin_elementwise_max(v0, (f32x4){0.f, 0.f, 0.f, 0.f}); v1 = __builtin_elementwise_max(v1, (f32x4){0.f, 0.f, 0.f, 0.f});
                    *(u32x4*)(H + (size_t)row * 4096 + col0 + bj * 8) = pack8(v0 * v0, v1 * v1);
                }
            }
    }
};
template <class Epi, class Sched, bool ALIGN_EPI = false, bool SP2 = false>
__device__ __forceinline__ void gemm_phase(PG8_LAS unsigned char* lds, const GemmL g, const Sched& S, const Epi& E) {
    int tid_ = threadIdx.x; asm volatile("" : "+v"(tid_));
    const int tid = tid_, wid = __builtin_amdgcn_readfirstlane(tid >> 6), lane = tid & 63, wr = wid >> 2, wc = wid & 3, fr = lane & 15, fq = lane >> 4;
    const int K = g.K, nt = K / BK, lda = g.lda;
    unsigned voffA[2], voffB[2];
#pragma unroll
    for (int i = 0; i < 2; ++i) { int R, C; stage_rc(tid * 16 + i * 8192, R, C); const int Rb = Epi::PERM == 2 ? (64 * (R >> 5) + 16 * ((R >> 2) & 3) + 4 * ((R >> 4) & 1) + (R & 3)) : Epi::PERM ? ((R & ~31) + perm32(R & 31)) : R;
        voffA[i] = (unsigned)(R * lda + C) * 2u; voffB[i] = (unsigned)(Rb * K + C) * 2u; }
    const size_t kstep = (size_t)(BK * 2);
    const size_t hstepA = (size_t)HALF * lda * 2, hstepB = Epi::PERM == 2 ? (size_t)8 * K * 2 : (size_t)HALF * K * 2;
    const size_t tstepA = 2 * hstepA, tstepB = (size_t)BM * K * 2;
    const unsigned ldsw = (unsigned)wid * 1024u;
    const int aoff = lds_byte(wr * 64 + fr, fq * 8), boff = lds_byte(wc * 32 + fr, fq * 8);
#define PG8_SA(b, h) (((b) * 2 + (h)) * HTB)
#define PG8_SB(b, h) ((4 + (b) * 2 + (h)) * HTB)
#define PG8_STAGE(bufoff, gbase, voff) do { _Pragma("unroll") for (int _i = 0; _i < 2; ++_i) \
        __builtin_amdgcn_global_load_lds((const unsigned*)((const char*)(gbase) + (voff)[_i]), (PG8_LAS unsigned*)(lds + (bufoff) + ldsw + _i * 8192), 16, 0, 0); } while (0)
#define PG8_LDA(dst, b, h) do { _Pragma("unroll") for (int m = 0; m < 4; ++m) _Pragma("unroll") for (int k = 0; k < 2; ++k) dst[m][k] = *(const PG8_LAS bf16x8*)(lds + PG8_SA(b, h) + aoff + m * 2048 + k * 1024); } while (0)
#define PG8_LDB(dst, b, h) do { _Pragma("unroll") for (int n = 0; n < 2; ++n) _Pragma("unroll") for (int k = 0; k < 2; ++k) dst[n][k] = *(const PG8_LAS bf16x8*)(lds + PG8_SB(b, h) + boff + n * 2048 + k * 1024); } while (0)
#define PG8_MMA(ai, bj, At, Bt) do { __builtin_amdgcn_s_setprio(1); _Pragma("unroll") for (int m = 0; m < 4; ++m) _Pragma("unroll") for (int n = 0; n < 2; ++n) _Pragma("unroll") for (int k = 0; k < 2; ++k) \
        acc[ai][bj][m][n] = __builtin_amdgcn_mfma_f32_16x16x32_bf16(Bt[n][k], At[m][k], acc[ai][bj][m][n], 0, 0, 0); __builtin_amdgcn_s_setprio(0); } while (0)
#define PG8_WAIT_V(n) asm volatile("s_waitcnt vmcnt(" #n ")" ::: "memory")
#define PG8_WAIT_L(n) asm volatile("s_waitcnt lgkmcnt(" #n ")" ::: "memory")
#define PG8_BAR __builtin_amdgcn_s_barrier()
#define PG8_SCHED __builtin_amdgcn_sched_barrier(0)
    Unit cur, nxt; int ui = 0;
    if (!S.next(0, cur)) return;
    f32x4 acc[2][2][4][2];
#pragma unroll
    for (int a = 0; a < 2; ++a)
#pragma unroll
        for (int b = 0; b < 2; ++b)
#pragma unroll
            for (int m = 0; m < 4; ++m)
#pragma unroll
                for (int n = 0; n < 2; ++n) acc[a][b][m][n] = (f32x4){0.f, 0.f, 0.f, 0.f};
    bf16x8 At[4][2], B0[2][2], B1[2][2];
    const char* cA = (const char*)g.A + (size_t)cur.pm * tstepA; const char* cB = (const char*)g.Bt + (size_t)cur.pn * tstepB;
    S.a_ready(cur);
    if constexpr (SP2) {
        PG8_STAGE(PG8_SB(0, 0), cB, voffB); PG8_STAGE(PG8_SB(0, 1), cB + hstepB, voffB); PG8_STAGE(PG8_SA(0, 0), cA, voffA); PG8_STAGE(PG8_SA(0, 1), cA + hstepA, voffA);
        if (wr == 1) PG8_BAR;
        PG8_WAIT_V(2); PG8_BAR;
        PG8_STAGE(PG8_SB(1, 0), cB + kstep, voffB); PG8_STAGE(PG8_SA(1, 0), cA + kstep, voffA); PG8_STAGE(PG8_SB(1, 1), cB + hstepB + kstep, voffB);
        PG8_WAIT_V(6); PG8_BAR;
    } else {
        PG8_STAGE(PG8_SB(0, 0), cB, voffB); PG8_STAGE(PG8_SA(0, 0), cA, voffA); PG8_STAGE(PG8_SB(0, 1), cB + hstepB, voffB); PG8_STAGE(PG8_SA(0, 1), cA + hstepA, voffA);
        if (wr == 1) PG8_BAR;
        PG8_WAIT_V(4); PG8_BAR;
        PG8_STAGE(PG8_SB(1, 0), cB + kstep, voffB); PG8_STAGE(PG8_SA(1, 0), cA + kstep, voffA); PG8_STAGE(PG8_SB(1, 1), cB + hstepB + kstep, voffB);
        PG8_WAIT_V(6); PG8_BAR;
    }
    for (;;) {
        const bool has_next = S.next(ui + 1, nxt);
        const char* nA = has_next ? (const char*)g.A + (size_t)nxt.pm * tstepA : cA; const char* nB = has_next ? (const char*)g.Bt + (size_t)nxt.pn * tstepB : cB;
        for (int t = 0; t < nt; t += 2) {
            const bool last = (t == nt - 2);
            const char* a1 = cA + (size_t)(t + 1) * kstep;
            const char* a2 = last ? nA : cA + (size_t)(t + 2) * kstep; const char* b2 = last ? nB : cB + (size_t)(t + 2) * kstep;
            const char* a3 = a2 + kstep; const char* b3 = b2 + kstep;
            if (last && has_next) S.a_ready(nxt);
            if constexpr (SP2) {
            PG8_LDB(B0, 0, 0); PG8_LDB(B1, 0, 1); PG8_SCHED; PG8_LDA(At, 0, 0); PG8_STAGE(PG8_SA(1, 1), a1 + hstepA, voffA);
            PG8_WAIT_V(8); PG8_WAIT_L(0); PG8_BAR; PG8_MMA(0, 0, At, B0); PG8_MMA(0, 1, At, B1); PG8_BAR; PG8_SCHED;
            PG8_LDA(At, 0, 1); PG8_STAGE(PG8_SB(0, 0), b2, voffB); PG8_STAGE(PG8_SB(0, 1), b2 + hstepB, voffB); PG8_STAGE(PG8_SA(0, 0), a2, voffA);
            PG8_WAIT_V(8); PG8_WAIT_L(0); PG8_BAR; PG8_MMA(1, 0, At, B0); PG8_MMA(1, 1, At, B1); PG8_BAR; PG8_SCHED;
            PG8_LDB(B0, 1, 0); PG8_LDB(B1, 1, 1); PG8_SCHED; PG8_LDA(At, 1, 0); PG8_STAGE(PG8_SA(0, 1), a2 + hstepA, voffA);
            PG8_WAIT_V(8); PG8_WAIT_L(0); PG8_BAR; PG8_MMA(0, 0, At, B0); PG8_MMA(0, 1, At, B1); PG8_BAR; PG8_SCHED;
            PG8_LDA(At, 1, 1); PG8_STAGE(PG8_SB(1, 0), b3, voffB); PG8_STAGE(PG8_SB(1, 1), b3 + hstepB, voffB); PG8_STAGE(PG8_SA(1, 0), a3, voffA);
            PG8_WAIT_V(8); PG8_WAIT_L(0); PG8_BAR; PG8_MMA(1, 0, At, B0); PG8_MMA(1, 1, At, B1); PG8_BAR; PG8_SCHED;
            } else {
            PG8_LDB(B0, 0, 0); PG8_SCHED; PG8_LDA(At, 0, 0); PG8_STAGE(PG8_SA(1, 1), a1 + hstepA, voffA);
            PG8_WAIT_L(8); PG8_BAR; PG8_WAIT_L(0); PG8_MMA(0, 0, At, B0); PG8_BAR; PG8_SCHED;
            PG8_LDB(B1, 0, 1); PG8_STAGE(PG8_SB(0, 0), b2, voffB);
            PG8_BAR; PG8_WAIT_L(0); PG8_MMA(0, 1, At, B1); PG8_BAR;
            PG8_LDA(At, 0, 1); PG8_STAGE(PG8_SA(0, 0), a2, voffA);
            PG8_BAR; PG8_WAIT_L(0); PG8_MMA(1, 0, At, B0); PG8_BAR; PG8_SCHED;
            PG8_STAGE(PG8_SB(0, 1), b2 + hstepB, voffB);
            PG8_WAIT_V(6); PG8_BAR; PG8_MMA(1, 1, At, B1); PG8_BAR;
            PG8_LDB(B0, 1, 0); PG8_SCHED; PG8_LDA(At, 1, 0); PG8_STAGE(PG8_SA(0, 1), a2 + hstepA, voffA);
            PG8_WAIT_L(8); PG8_BAR; PG8_WAIT_L(0); PG8_MMA(0, 0, At, B0); PG8_BAR; PG8_SCHED;
            PG8_LDB(B1, 1, 1); PG8_STAGE(PG8_SB(1, 0), b3, voffB);
            PG8_BAR; PG8_WAIT_L(0); PG8_MMA(0, 1, At, B1); PG8_BAR;
            PG8_LDA(At, 1, 1); PG8_STAGE(PG8_SA(1, 0), a3, voffA);
            PG8_BAR; PG8_WAIT_L(0); PG8_MMA(1, 0, At, B0); PG8_BAR; PG8_SCHED;
            PG8_STAGE(PG8_SB(1, 1), b3 + hstepB, voffB);
            PG8_WAIT_V(6); PG8_BAR; PG8_MMA(1, 1, At, B1); PG8_BAR;
            }
        }
        if constexpr (ALIGN_EPI) { if (wr == 0) PG8_BAR; }
        if constexpr (!Epi::AFTER_DRAIN) { E(acc, cur, wr, wc, fr, fq); S.done(cur); }
        if (!has_next) break;
#pragma unroll
        for (int a = 0; a < 2; ++a)
#pragma unroll
            for (int b = 0; b < 2; ++b)
#pragma unroll
                for (int m = 0; m < 4; ++m)
#pragma unroll
                    for (int n = 0; n < 2; ++n) acc[a][b][m][n] = (f32x4){0.f, 0.f, 0.f, 0.f};
        cur = nxt; cA = nA; cB = nB; ++ui;
        if constexpr (ALIGN_EPI) { if (wr == 1) PG8_BAR; }
    }
    PG8_WAIT_V(0);
    if constexpr (!ALIGN_EPI) { if (wr == 0) PG8_BAR; }
    PG8_BAR;
    if constexpr (Epi::AFTER_DRAIN) { E.fused(acc, cur, wr, wc, fr, fq, lds, wid, lane); S.done(cur); }
#undef PG8_SA
#undef PG8_SB
#undef PG8_STAGE
#undef PG8_LDA
#undef PG8_LDB
#undef PG8_MMA
#undef PG8_WAIT_V
#undef PG8_WAIT_L
#undef PG8_BAR
#undef PG8_SCHED
}
}
using pg8::bf16_t; using pg8::bf16x8; using pg8::f32x4; using pg8::u32x4;
#define LAS __attribute__((address_space(3)))
typedef float f32x2 __attribute__((ext_vector_type(2)));
typedef unsigned u32x2 __attribute__((ext_vector_type(2)));
#define LDS_WAIT() asm volatile("s_waitcnt lgkmcnt(0)" ::: "memory")

constexpr int BATCH = 8, SEQ = 4096, D = 1024, NIN = 7168, FF = 4096, DEPTH = 4, CHUNK = 128, NH = 8;
constexpr int M = BATCH * SEQ;
constexpr int NWAVES = 8, NTHR = 512;
constexpr size_t MiB = 1u << 20;
constexpr size_t WS_WIN = 0;
constexpr size_t WS_WOUT = 56 * MiB;
constexpr size_t WS_W1 = 64 * MiB;
constexpr size_t WS_W2 = 96 * MiB;
constexpr size_t WS_SGU = 128 * MiB;
constexpr size_t WS_SSX = 129 * MiB;
constexpr size_t WS_LNP = 131 * MiB;
constexpr size_t WS_XB = 136 * MiB;
constexpr size_t WS_P = 200 * MiB;
constexpr size_t WS_CTL = 456 * MiB, CTL_BYTES = 65536;
constexpr size_t WS_END = 457 * MiB;
constexpr int LDS_XB = 139264;
constexpr int LDS_BYTES = 140288;

__device__ __forceinline__ float wave_sum(float v) {
#pragma unroll
    for (int o = 1; o < 64; o <<= 1) v += __shfl_xor(v, o);
    return v;
}
__device__ __forceinline__ int inv_map_in(int src) {
    const int sec = src >> 10, ch = src & 1023;
    if (sec == 4) return 6144 + ch;
    const int type = (sec == 0 || sec == 2) ? 0 : (sec == 1 || sec == 5) ? 1 : 2, half = (sec == 2 || sec == 5 || sec == 6) ? 1 : 0;
    const int j = ch >> 7, r = ch & 127;
    return type * 2048 + 256 * j + 16 * (r >> 3) + 8 * half + (r & 7);
}
template <bool MAP> __device__ __forceinline__ void transpose_item(const float* W, int N, int n0src, const float* gk, bf16_t* WT, int K, int n0dst, int k0, LAS float* scr, int lane) {
#pragma unroll
    for (int i = 0; i < 32; ++i) { const int kk = 2 * i + (lane >> 5); float v = W[(size_t)(k0 + kk) * N + n0src + (lane & 31)]; if (gk) v *= gk[k0 + kk]; scr[kk * 33 + (lane & 31)] = v; }
    LDS_WAIT(); asm volatile("" ::: "memory");
    const int c = lane & 7;
#pragma unroll
    for (int jj = 0; jj < 4; ++jj) { const int n = (lane >> 3) + 8 * jj; const LAS float* s = scr + (8 * c) * 33 + n;
        u32x4 o; o.x = pg8::cvt_pk_bf16(s[0 * 33], s[1 * 33]); o.y = pg8::cvt_pk_bf16(s[2 * 33], s[3 * 33]); o.z = pg8::cvt_pk_bf16(s[4 * 33], s[5 * 33]); o.w = pg8::cvt_pk_bf16(s[6 * 33], s[7 * 33]);
        *(u32x4*)(WT + (size_t)(MAP ? inv_map_in(n0src + n) : n0dst + n) * K + k0 + 8 * c) = o; }
    LDS_WAIT(); asm volatile("" ::: "memory");
}

struct Args { const float* in[13]; float* out; unsigned char* ws; };

__device__ __forceinline__ void p0_prologue(const Args& a, LAS unsigned char* lds) {
    const int tid = threadIdx.x, lane = tid & 63, wave = __builtin_amdgcn_readfirstlane(tid >> 6);
    const int gw = blockIdx.x * NWAVES + wave, NGW = gridDim.x * NWAVES;
    LAS float* scr = (LAS float*)(lds + wave * 16384);
    const float* norm_mix = a.in[1]; const float* w_in = a.in[2]; const float* w_out = a.in[8]; const float* norm_mlp = a.in[9]; const float* w_ff1 = a.in[10]; const float* w_ff2 = a.in[11];
    bf16_t* WIN = (bf16_t*)(a.ws + WS_WIN); bf16_t* WOUT = (bf16_t*)(a.ws + WS_WOUT); bf16_t* W1 = (bf16_t*)(a.ws + WS_W1); bf16_t* W2 = (bf16_t*)(a.ws + WS_W2);
    constexpr int I_IN = 16 * (NIN / 32), I_OUT = 16 * (D / 32), I_1 = 16 * (FF / 32), I_2 = (FF / 64) * (D / 32), I_L = I_IN + I_OUT + I_1 + I_2;
    for (int it = gw; it < DEPTH * I_L; it += NGW) {
        const int l = it / I_L; int r = it % I_L;
        if (r < I_IN) { const int kb = r / (NIN / 32), nb = r % (NIN / 32); transpose_item<true>(w_in + (size_t)l * D * NIN, NIN, 32 * nb, norm_mix + l * D, WIN + (size_t)l * NIN * D, D, 32 * nb, 64 * kb, scr, lane); continue; } r -= I_IN;
        if (r < I_OUT) { const int kb = r / (D / 32), nb = r % (D / 32); transpose_item<false>(w_out + (size_t)l * D * D, D, 32 * nb, nullptr, WOUT + (size_t)l * D * D, D, 32 * nb, 64 * kb, scr, lane); continue; } r -= I_OUT;
        if (r < I_1) { const int kb = r / (FF / 32), nb = r % (FF / 32); transpose_item<false>(w_ff1 + (size_t)l * D * FF, FF, 32 * nb, norm_mlp + l * D, W1 + (size_t)l * FF * D, D, 32 * nb, 64 * kb, scr, lane); continue; } r -= I_1;
        { const int kb = r / (D / 32), nb = r % (D / 32); transpose_item<false>(w_ff2 + (size_t)l * FF * D, D, 32 * nb, nullptr, W2 + (size_t)l * D * FF, FF, 32 * nb, 64 * kb, scr, lane); }
    }
    const float* x = a.in[0]; bf16_t* XB = (bf16_t*)(a.ws + WS_XB); float* ssx = (float*)(a.ws + WS_SSX);
    for (int m = gw; m < M; m += NGW) {
        const f32x4* xr = (const f32x4*)(x + (size_t)m * D) + lane; float s = 0.f; f32x4 v[4];
#pragma unroll
        for (int j = 0; j < 4; ++j) { v[j] = xr[64 * j]; s += pg8::hsum4(v[j] * v[j]); }
        s = wave_sum(s);
        u32x2* o = (u32x2*)(XB + (size_t)m * D) + lane;
#pragma unroll
        for (int j = 0; j < 4; ++j) { u32x2 w; w.x = pg8::cvt_pk_bf16(v[j][0], v[j][1]); w.y = pg8::cvt_pk_bf16(v[j][2], v[j][3]); o[64 * j] = w; }
        if (lane < 16) ssx[(size_t)m * 16 + lane] = lane == 0 ? s : 0.f;
    }
    const float* sw = a.in[4]; bf16_t* SG = (bf16_t*)(a.ws + WS_SGU);
    for (int e = blockIdx.x * NTHR + tid; e < DEPTH * NH * CHUNK * CHUNK / 4; e += gridDim.x * NTHR) {
        const f32x4 v = *((const f32x4*)sw + e); const int s0 = (e * 4) & 127, t = ((e * 4) >> 7) & 127;
        u32x2 w; w.x = pg8::cvt_pk_bf16(s0 <= t ? v[0] : 0.f, s0 + 1 <= t ? v[1] : 0.f); w.y = pg8::cvt_pk_bf16(s0 + 2 <= t ? v[2] : 0.f, s0 + 3 <= t ? v[3] : 0.f);
        *((u32x2*)SG + e) = w;
    }
}

constexpr int VN_STRIDE = 272;
constexpr int MX_STRIDE = 132;
constexpr int LDS_VN = 0, LDS_MX = 128 * VN_STRIDE, LDS_ST = LDS_MX + 128 * MX_STRIDE * 4;
constexpr int LDS_WS = LDS_ST + 1024;
static_assert(LDS_WS + 128 * VN_STRIDE <= LDS_XB, "mixer LDS map");
#define MIX_BAR() do { asm volatile("s_waitcnt lgkmcnt(0)" ::: "memory"); __builtin_amdgcn_s_barrier(); asm volatile("" ::: "memory"); } while (0)
#define UNP0(r) ((f32x4){pg8::bf_lo(r.x), pg8::bf_hi(r.x), pg8::bf_lo(r.y), pg8::bf_hi(r.y)})
#define UNP1(r) ((f32x4){pg8::bf_lo(r.z), pg8::bf_hi(r.z), pg8::bf_lo(r.w), pg8::bf_hi(r.w)})
__device__ __forceinline__ void mixer_phase(LAS unsigned char* lds, bf16_t* P, const float* lnp, const float* lng, const float* lnb, const bf16_t* Wsb, const float* bs, const float* cw) {
    int tid_ = threadIdx.x; asm volatile("" : "+v"(tid_));
    const int tid = tid_, lane = tid & 63, w = __builtin_amdgcn_readfirstlane(tid >> 6), fr = lane & 15, fq = lane >> 4;
    const int dc = tid & 15, sr = tid >> 4;
    const int h = blockIdx.x & 7, bh = blockIdx.x >> 3, nbh = ((int)gridDim.x - h + 7) >> 3, d0 = h * 128 + 8 * dc;
    const int NCH = M / CHUNK;
    LAS f32x2* ST = (LAS f32x2*)(lds + LDS_ST);
    float bsv[8];
#pragma unroll
    for (int i = 0; i < 8; ++i) bsv[i] = bs[h * 128 + 16 * i + fr];
#pragma unroll
    for (int j = 0; j < 4; ++j) { const int t = sr + 32 * j; *(LAS u32x4*)(lds + LDS_WS + t * VN_STRIDE + dc * 16) = *(const u32x4*)(Wsb + (size_t)(h * 128 + t) * 128 + 8 * dc); }
    const f32x4 g0 = *(const f32x4*)(lng + d0), g1 = *(const f32x4*)(lng + d0 + 4), b0 = *(const f32x4*)(lnb + d0), b1 = *(const f32x4*)(lnb + d0 + 4);
    f32x4 w0[2], w1[2], w2[2];
#pragma unroll
    for (int k = 0; k < 2; ++k) { w0[k] = *(const f32x4*)(cw + d0 + 4 * k); w1[k] = *(const f32x4*)(cw + 1024 + d0 + 4 * k); w2[k] = *(const f32x4*)(cw + 2048 + d0 + 4 * k); }
    u32x4 nraw[4]; f32x4 nst[2];
    int cn = bh;
    if (cn < NCH) {
#pragma unroll
        for (int j = 0; j < 4; ++j) nraw[j] = *(const u32x4*)(P + (size_t)(cn * CHUNK + sr + 32 * j) * pg8::PW + 3072 + d0);
        const f32x4* p = (const f32x4*)(lnp + (size_t)(cn * CHUNK + (tid >> 2)) * 32 + 8 * (tid & 3)); nst[0] = p[0]; nst[1] = p[1];
    }
    for (; cn < NCH; cn += nbh) {
        const int row0 = cn * CHUNK;
        u32x4 pc0[4], pc1[4], pc2[4], pbg[4], pug[4];
        const u32x4 zero = (u32x4){0u, 0u, 0u, 0u};
#pragma unroll
        for (int j = 0; j < 4; ++j) {
            const int t = sr + 32 * j, pos = (cn & 31) * CHUNK + t; const bf16_t* rp = P + (size_t)(row0 + t) * pg8::PW + d0;
            pc0[j] = *(const u32x4*)rp; pc1[j] = pos >= 1 ? *(const u32x4*)(rp - pg8::PW) : zero; pc2[j] = pos >= 2 ? *(const u32x4*)(rp - 2 * pg8::PW) : zero;
            pbg[j] = *(const u32x4*)(rp + 1024); pug[j] = *(const u32x4*)(rp + 2048);
        }
        {
            float s = (nst[0][0] + nst[0][2]) + (nst[1][0] + nst[1][2]), q = (nst[0][1] + nst[0][3]) + (nst[1][1] + nst[1][3]);
            s += __shfl_xor(s, 1); s += __shfl_xor(s, 2); q += __shfl_xor(q, 1); q += __shfl_xor(q, 2);
            const float mean = s * (1.0f / D), var = fmaxf(q * (1.0f / D) - mean * mean, 0.f);
            if ((tid & 3) == 0) ST[tid >> 2] = (f32x2){mean, rsqrtf(var + pg8::EPS)};
        }
        MIX_BAR();
#pragma unroll
        for (int j = 0; j < 4; ++j) {
            const int s = sr + 32 * j; const f32x2 st = ST[s];
            const f32x4 v0 = (UNP0(nraw[j]) - st.x) * st.y * g0 + b0, v1 = (UNP1(nraw[j]) - st.x) * st.y * g1 + b1;
            *(LAS u32x4*)(lds + LDS_VN + s * VN_STRIDE + dc * 16) = pg8::pack8(v0, v1);
        }
        MIX_BAR();
        {
            bf16x8 av[4];
#pragma unroll
            for (int kk = 0; kk < 4; ++kk)
#pragma unroll
                for (int e = 0; e < 8; ++e) av[kk][e] = *(const LAS short*)(lds + LDS_VN + (32 * kk + 8 * fq + e) * VN_STRIDE + (16 * w + fr) * 2);
#pragma unroll
            for (int i = 0; i < 8; ++i) {
                f32x4 acc = (f32x4){0.f, 0.f, 0.f, 0.f};
#pragma unroll
                for (int kk = 0; kk < 4; ++kk) if (kk <= i / 2) acc = __builtin_amdgcn_mfma_f32_16x16x32_bf16(av[kk], *(const LAS bf16x8*)(lds + LDS_WS + (16 * i + fr) * VN_STRIDE + (32 * kk + 8 * fq) * 2), acc, 0, 0, 0);
                acc = acc + bsv[i];
                *(LAS f32x4*)(lds + LDS_MX + ((16 * i + fr) * MX_STRIDE + 16 * w + 4 * fq) * 4) = acc;
            }
        }
        MIX_BAR();
        if (cn + nbh < NCH) {
            const int nr0 = (cn + nbh) * CHUNK;
#pragma unroll
            for (int j = 0; j < 4; ++j) nraw[j] = *(const u32x4*)(P + (size_t)(nr0 + sr + 32 * j) * pg8::PW + 3072 + d0);
            const f32x4* p = (const f32x4*)(lnp + (size_t)(nr0 + (tid >> 2)) * 32 + 8 * (tid & 3)); nst[0] = p[0]; nst[1] = p[1];
        }
#pragma unroll
        for (int j = 0; j < 4; ++j) {
            const int t = sr + 32 * j; bf16_t* rp = P + (size_t)(row0 + t) * pg8::PW + d0;
            const LAS f32x4* mx = (const LAS f32x4*)(lds + LDS_MX + (t * MX_STRIDE + 8 * dc) * 4);
            const f32x4 m0 = mx[0], m1 = mx[1];
            const f32x4 o0 = UNP0(pbg[j]) * (w0[0] * UNP0(pc2[j]) + w1[0] * UNP0(pc1[j]) + w2[0] * UNP0(pc0[j])) + UNP0(pug[j]) * m0;
            const f32x4 o1 = UNP1(pbg[j]) * (w0[1] * UNP1(pc2[j]) + w1[1] * UNP1(pc1[j]) + w2[1] * UNP1(pc0[j])) + UNP1(pug[j]) * m1;
            *(u32x4*)(rp + 1024) = pg8::pack8(o0, o1);
        }
    }
    asm volatile("s_waitcnt vmcnt(0) lgkmcnt(0)" ::: "memory"); __builtin_amdgcn_s_barrier(); asm volatile("" ::: "memory");
}
#undef UNP0
#undef UNP1

__device__ __forceinline__ void final_phase(const bf16_t* XB, const float* fn, float* out) {
    const int tid = threadIdx.x, lane = tid & 63, wave = tid >> 6; const int gw = blockIdx.x * NWAVES + wave, NGW = gridDim.x * NWAVES;
    f32x4 g[2][2];
#pragma unroll
    for (int j = 0; j < 2; ++j) { g[j][0] = *(const f32x4*)(fn + 8 * lane + 512 * j); g[j][1] = *(const f32x4*)(fn + 8 * lane + 512 * j + 4); }
    for (int m = gw; m < M; m += NGW) {
        f32x4 v[2][2]; float s = 0.f;
#pragma unroll
        for (int j = 0; j < 2; ++j) { const u32x4 r = *(const u32x4*)(XB + (size_t)m * D + 8 * lane + 512 * j);
            v[j][0] = (f32x4){pg8::bf_lo(r.x), pg8::bf_hi(r.x), pg8::bf_lo(r.y), pg8::bf_hi(r.y)}; v[j][1] = (f32x4){pg8::bf_lo(r.z), pg8::bf_hi(r.z), pg8::bf_lo(r.w), pg8::bf_hi(r.w)};
            s += pg8::hsum4(v[j][0] * v[j][0]) + pg8::hsum4(v[j][1] * v[j][1]); }
        const float rs = rsqrtf(wave_sum(s) * (1.0f / D) + pg8::EPS);
#pragma unroll
        for (int j = 0; j < 2; ++j) { f32x4* o = (f32x4*)(out + (size_t)m * D + 8 * lane + 512 * j); o[0] = v[j][0] * rs * g[j][0]; o[1] = v[j][1] * rs * g[j][1]; }
    }
}

#define XB_TMO      128
#define XB_XCNT(j)  (256  + 64 * (j))
#define XB_XSUB(j)  (1280 + 64 * (j))
#define XB_XGEN(j)  (2304 + 64 * (j))
#define XB_TOP      3328
#define XB_TOPGEN   3392
#define XCD_BAR_WORDS 3456
#define XB_SPIN_CAP (1u << 18)

__device__ __forceinline__ unsigned xb_ld(unsigned* p)              { return __hip_atomic_load(p, __ATOMIC_RELAXED, __HIP_MEMORY_SCOPE_AGENT); }
__device__ __forceinline__ unsigned xb_add(unsigned* p, unsigned v) { return __hip_atomic_fetch_add(p, v, __ATOMIC_RELAXED, __HIP_MEMORY_SCOPE_AGENT); }
__device__ __forceinline__ unsigned xb_xcc_id() { return (unsigned)__builtin_amdgcn_s_getreg((3 << 11) | 20) & 0xFu; }
#define XB_SPIN(cond, bar) do { unsigned _sp = 0; while (cond) { __builtin_amdgcn_s_sleep(1); \
    if ((++_sp & 255u) == 0u) { if (xb_ld(&(bar)[XB_TMO])) break; if (_sp > XB_SPIN_CAP) { atomicAdd(&(bar)[XB_TMO], 1u); break; } } } } while (0)

struct XcdBarrier {
    unsigned* bar; unsigned x;
    volatile LAS unsigned* st;
};

__device__ __forceinline__ XcdBarrier xcd_barrier_post(unsigned* bar, volatile LAS unsigned* st) {
    XcdBarrier b; b.bar = bar; b.x = xb_xcc_id(); b.st = st;
    if (threadIdx.x == 0) (void)xb_add(&bar[XB_XCNT(b.x)], 1u);
    return b;
}
__device__ __forceinline__ void xcd_barrier_complete(unsigned* bar, unsigned x, unsigned& nloc, unsigned& nx) {
    const unsigned G = gridDim.x * gridDim.y * gridDim.z;
    unsigned sum, cnt, mine, sp = 0u;
    for (;;) {
        sum = 0u; cnt = 0u; mine = 0u;
#pragma unroll
        for (unsigned j = 0; j < 16; ++j) { const unsigned c = xb_ld(&bar[XB_XCNT(j)]); sum += c; cnt += (c > 0u) ? 1u : 0u; mine = (j == x) ? c : mine; }
        if (sum == G) break;
        __builtin_amdgcn_s_sleep(1);
        if ((++sp & 255u) == 0u) { if (xb_ld(&bar[XB_TMO])) break; if (sp > XB_SPIN_CAP) { atomicAdd(&bar[XB_TMO], 1u); break; } }
    }
    nloc = mine > 0u ? mine : 1u; nx = cnt > 0u ? cnt : 1u;
}

__device__ __forceinline__ void xcd_barrier(const XcdBarrier& b) {
    asm volatile("s_waitcnt vmcnt(0)" ::: "memory");
    __syncthreads();
    if (threadIdx.x == 0) {
        unsigned* bar = b.bar;
        __builtin_amdgcn_s_waitcnt(0);
        unsigned nloc = b.st[0], nx = b.st[1];
        if (nloc == 0u) { xcd_barrier_complete(bar, b.x, nloc, nx); b.st[0] = nloc; b.st[1] = nx; }
        const unsigned old = xb_add(&bar[XB_XSUB(b.x)], 1u);
        const unsigned gen = old / nloc;
        if (old + 1u == (gen + 1u) * nloc) {
            __builtin_amdgcn_fence(__ATOMIC_RELEASE, "agent");
            asm volatile("s_waitcnt vmcnt(0)" ::: "memory");
            const unsigned og = xb_add(&bar[XB_TOP], 1u);
            const unsigned tg = og / nx;
            if (og + 1u == (tg + 1u) * nx) xb_add(&bar[XB_TOPGEN], 1u);
            else XB_SPIN(xb_ld(&bar[XB_TOPGEN]) == tg, bar);
            __builtin_amdgcn_fence(__ATOMIC_ACQUIRE, "agent");
            xb_add(&bar[XB_XGEN(b.x)], 1u);
            asm volatile("s_waitcnt vmcnt(0)" ::: "memory");
        } else {
            XB_SPIN(xb_ld(&bar[XB_XGEN(b.x)]) == gen, bar);
            __builtin_amdgcn_fence(__ATOMIC_ACQUIRE, "agent");
            asm volatile("s_waitcnt vmcnt(0)" ::: "memory");
        }
    }
    __syncthreads();
}

__global__ void __launch_bounds__(NTHR, 2) fwd_megakernel(Args a) {
    extern __shared__ __attribute__((aligned(16))) unsigned char lds_raw[];
    LAS unsigned char* lds = (LAS unsigned char*)lds_raw;
    cg::grid_group grid = cg::this_grid();
    unsigned char* ws = a.ws;
    bf16_t* XB = (bf16_t*)(ws + WS_XB); bf16_t* P = (bf16_t*)(ws + WS_P); float* ssx = (float*)(ws + WS_SSX); float* lnp = (float*)(ws + WS_LNP);
    const int G = gridDim.x, c = blockIdx.x;
    if (threadIdx.x < 2) ((LAS unsigned*)(lds + LDS_XB))[threadIdx.x] = 0u;
    __syncthreads();
    const XcdBarrier bar = xcd_barrier_post((unsigned*)(ws + WS_CTL), (volatile LAS unsigned*)(lds + LDS_XB));

    p0_prologue(a, lds);
    grid.sync();
#pragma unroll 1
    for (int l = 0; l < DEPTH; ++l) {
        {
            pg8::GemmL g{XB, (const bf16_t*)(ws + WS_WIN) + (size_t)l * NIN * D, M, NIN, D, D}; pg8::StaticOrder S; S.init(M, NIN, G, c);
            pg8::EpiIn E{P, ssx, lnp};
            pg8::gemm_phase<pg8::EpiIn, pg8::StaticOrder, true, true>(lds, g, S, E);
        }
        xcd_barrier(bar);
        mixer_phase(lds, P, lnp, a.in[6] + l * D, a.in[7] + l * D, (const bf16_t*)(ws + WS_SGU) + (size_t)l * NH * CHUNK * CHUNK, a.in[5] + l * NH * CHUNK, a.in[3] + l * 3 * D);
        xcd_barrier(bar);
        {
            pg8::GemmL g{P + 1024, (const bf16_t*)(ws + WS_WOUT) + (size_t)l * D * D, M, D, D, pg8::PW}; pg8::StaticOrder S; S.init(M, D, G, c);
            pg8::EpiRes E{XB, ssx};
            pg8::gemm_phase<pg8::EpiRes, pg8::StaticOrder, true, true>(lds, g, S, E);
        }
        xcd_barrier(bar);
        {
            pg8::GemmL g{XB, (const bf16_t*)(ws + WS_W1) + (size_t)l * FF * D, M, FF, D, D}; pg8::StaticOrder S; S.init(M, FF, G, c);
            pg8::EpiFF1 E{P, ssx};
            pg8::gemm_phase<pg8::EpiFF1, pg8::StaticOrder, true, true>(lds, g, S, E);
        }
        xcd_barrier(bar);
        {
            pg8::GemmL g{P, (const bf16_t*)(ws + WS_W2) + (size_t)l * D * FF, M, D, FF, FF}; pg8::StaticOrder S; S.init(M, D, G, c);
            pg8::EpiRes E{XB, ssx};
            pg8::gemm_phase<pg8::EpiRes, pg8::StaticOrder, true, true>(lds, g, S, E);
        }
        xcd_barrier(bar);
    }
    final_phase(XB, a.in[12], a.out);
}

extern "C" void kernel_launch(void* const* d_in, const int* in_sizes, int n_in, void* d_out, int out_size, void* d_ws, size_t ws_size, hipStream_t stream) {
    static int grid = 0;
    if (grid == 0) {
        if (n_in != 13 || ws_size < WS_END) { fprintf(stderr, "kernel_launch: unexpected inputs (n_in %d, ws %zu)\n", n_in, ws_size); grid = -1; return; }
        int dev = 0, cus = 0, per_cu = 0;
        hipGetDevice(&dev); hipDeviceGetAttribute(&cus, hipDeviceAttributeMultiprocessorCount, dev);
        hipFuncSetAttribute((const void*)fwd_megakernel, hipFuncAttributeMaxDynamicSharedMemorySize, LDS_BYTES);
        if (hipOccupancyMaxActiveBlocksPerMultiprocessor(&per_cu, (const void*)fwd_megakernel, NTHR, LDS_BYTES) != hipSuccess || per_cu < 1) { fprintf(stderr, "kernel_launch: occupancy query says %d\n", per_cu); per_cu = 1; }
        (void)hipGetLastError();
        grid = cus * per_cu;
    }
    if (grid < 0) return;
    Args a{};
    for (int i = 0; i < 13; ++i) a.in[i] = (const float*)d_in[i];
    a.out = (float*)d_out; a.ws = (unsigned char*)d_ws;
    if (hipMemsetAsync((char*)d_ws + WS_CTL, 0, CTL_BYTES, stream) != hipSuccess) { fprintf(stderr, "memset failed\n"); return; }
    void* args[] = {&a};
    hipError_t e = hipLaunchCooperativeKernel((const void*)fwd_megakernel, dim3(grid), dim3(NTHR), args, LDS_BYTES, stream);
    if (e != hipSuccess) fprintf(stderr, "cooperative launch failed: %s (grid %d)\n", hipGetErrorString(e), grid);
}
```

```cpp
#include <hip/hip_runtime.h>
#include <hip/hip_cooperative_groups.h>
#include <cstdio>
#include <cstdint>
namespace cg = cooperative_groups;
namespace pg8 {
#define PG8_LAS __attribute__((address_space(3)))
typedef unsigned short bf16_t;
typedef short bf16x8 __attribute__((ext_vector_type(8)));
typedef float f32x4 __attribute__((ext_vector_type(4)));
typedef unsigned u32x4 __attribute__((ext_vector_type(4)));
constexpr int BM = 256, BK = 64, HALF = 128, HTB = HALF * BK * 2  , STAGE_BYTES = 8 * HTB, NXCD = 8, WGM = 8;

__host__ __device__ __forceinline__ int lds_byte(int r, int c) { const int st = (r >> 4) * 2 + (c >> 5), rr = r & 15, cc = c & 31, ob = rr * 64 + cc * 2; return st * 1024 + (ob ^ (((ob >> 9) & 1) << 5)); }
__host__ __device__ __forceinline__ void stage_rc(int b, int& R, int& C) { const int st = b / 1024, sb = b % 1024, swz = sb ^ (((sb >> 9) & 1) << 5); R = (st >> 1) * 16 + swz / 64; C = (st & 1) * 32 + (swz % 64) / 2; }
__host__ __device__ __forceinline__ int perm32(int rho) { const int n = rho >> 4, i = rho & 15; return 8 * (i >> 2) + 4 * n + (i & 3); }

struct Unit { int pm, pn; };
struct Gemm { const bf16_t* A; const bf16_t* Bt; int M, N, K; };

struct StaticOrder {
    int nM, nN, nwg, G, c;
    __host__ __device__ void init(int M, int N, int G_, int c_) { nM = M / BM; nN = N / BM; nwg = nM * nN; G = G_; c = c_; }
    __host__ __device__ bool next(int i, Unit& u) const {
        const long L = (long)i * G + c; if (L >= nwg) return false;
        int wgid = (int)L; { const int q = nwg / NXCD, r = nwg % NXCD, xcd = wgid % NXCD, off = wgid / NXCD; wgid = (xcd < r ? xcd * (q + 1) : r * (q + 1) + (xcd - r) * q) + off; }
        const int nig = WGM * nN, gid = wgid / nig, fm = gid * WGM, gsz = (nM - fm) < WGM ? (nM - fm) : WGM;
        u.pm = fm + ((wgid % nig) % gsz); u.pn = (wgid % nig) / gsz; return true;
    }
    __device__ __forceinline__ void a_ready(const Unit&) const {}
    __device__ __forceinline__ void done(const Unit&) const {}
};

struct XcdOrder {
    int nN, nloc, rank, xi, nx, per;
    __host__ __device__ void init(int N, int nloc_, int rank_, int xi_, int nx_) { nN = N / BM; nloc = nloc_; rank = rank_; xi = xi_; nx = nx_; per = 16 * nN; }
    __host__ __device__ bool next(int i, Unit& u) const {
        const int L = i * nloc + rank, k = L / per, b = xi + k * nx; if (b >= 8) return false;
        const int w = L % per, nig = 4 * nN, gid = w / nig, ww = w % nig;
        u.pm = b * 16 + gid * 4 + (ww & 3); u.pn = ww >> 2; return true;
    }
    __device__ __forceinline__ void a_ready(const Unit&) const {}
    __device__ __forceinline__ void done(const Unit&) const {}
};
struct GemmL { const bf16_t* A; const bf16_t* Bt; int M, N, K, lda; };
__device__ __forceinline__ unsigned cvt_pk_bf16(float lo, float hi) { unsigned r; asm volatile("v_cvt_pk_bf16_f32 %0, %1, %2" : "=v"(r) : "v"(lo), "v"(hi)); return r; }
__device__ __forceinline__ float bf_lo(unsigned w) { return __uint_as_float(w << 16); }
__device__ __forceinline__ float bf_hi(unsigned w) { return __uint_as_float(w & 0xffff0000u); }
__device__ __forceinline__ float sigm(float x) { return __builtin_amdgcn_rcpf(1.f + __builtin_amdgcn_exp2f(-1.4426950408889634f * x)); }
__device__ __forceinline__ float gelu_t(float x) { const float u = x * (1.5957691216057308f + 0.0713548162726f * x * x); return x * __builtin_amdgcn_rcpf(1.f + __builtin_amdgcn_exp2f(-1.4426950408889634f * u)); }
__device__ __forceinline__ f32x4 sigm4(f32x4 v) { return (f32x4){sigm(v[0]), sigm(v[1]), sigm(v[2]), sigm(v[3])}; }
__device__ __forceinline__ f32x4 gelu4(f32x4 v) { return (f32x4){gelu_t(v[0]), gelu_t(v[1]), gelu_t(v[2]), gelu_t(v[3])}; }
__device__ __forceinline__ u32x4 pack8(f32x4 a, f32x4 b) { u32x4 w; w.x = cvt_pk_bf16(a[0], a[1]); w.y = cvt_pk_bf16(a[2], a[3]); w.z = cvt_pk_bf16(b[0], b[1]); w.w = cvt_pk_bf16(b[2], b[3]); return w; }
__device__ __forceinline__ float hsum4(f32x4 a) { return (a[0] + a[1]) + (a[2] + a[3]); }
constexpr float EPS = 1e-6f;
constexpr int DM = 1024, PW = 4096;
__device__ __forceinline__ void rows_rstd(float (&rs)[2][4], const float* ssx, int row0, int fq) {
    f32x4 p[2][4];
#pragma unroll
    for (int ai = 0; ai < 2; ++ai)
#pragma unroll
        for (int m = 0; m < 4; ++m) p[ai][m] = *(const f32x4*)(ssx + (size_t)(row0 + ai * HALF + m * 16) * 16 + 4 * fq);
#pragma unroll
    for (int ai = 0; ai < 2; ++ai)
#pragma unroll
        for (int m = 0; m < 4; ++m) rs[ai][m] = hsum4(p[ai][m]);
#pragma unroll
    for (int ai = 0; ai < 2; ++ai)
#pragma unroll
        for (int m = 0; m < 4; ++m) rs[ai][m] += __shfl_xor(rs[ai][m], 16);
#pragma unroll
    for (int ai = 0; ai < 2; ++ai)
#pragma unroll
        for (int m = 0; m < 4; ++m) rs[ai][m] += __shfl_xor(rs[ai][m], 32);
#pragma unroll
    for (int ai = 0; ai < 2; ++ai)
#pragma unroll
        for (int m = 0; m < 4; ++m) rs[ai][m] = rsqrtf(rs[ai][m] * (1.0f / DM) + EPS);
}
struct EpiIn {
    static constexpr int PERM = 2; static constexpr bool AFTER_DRAIN = false;
    bf16_t* P; const float* ssx; float* lnp;
    __device__ __forceinline__ void operator()(const f32x4 (&acc)[2][2][4][2], const Unit& u, int wr, int wc, int fr, int fq) const {
        const int row0 = u.pm * BM + wr * 64 + fr, type = u.pn >> 3, j = u.pn & 7, cb = wc * 32 + 8 * fq;
        float rs[2][4]; rows_rstd(rs, ssx, row0, fq);
        if (type == 3) {
            float sv[2][4], qv[2][4];
#pragma unroll
            for (int ai = 0; ai < 2; ++ai)
#pragma unroll
                for (int m = 0; m < 4; ++m) {
                    const float r = rs[ai][m]; bf16_t* rp = P + (size_t)(row0 + ai * HALF + m * 16) * PW;
                    const f32x4 a0 = gelu4(acc[ai][0][m][0] * r), a1 = gelu4(acc[ai][0][m][1] * r), b0 = gelu4(acc[ai][1][m][0] * r), b1 = gelu4(acc[ai][1][m][1] * r);
                    sv[ai][m] = (hsum4(a0) + hsum4(a1)) + (hsum4(b0) + hsum4(b1));
                    qv[ai][m] = (hsum4(a0 * a0) + hsum4(a1 * a1)) + (hsum4(b0 * b0) + hsum4(b1 * b1));
                    *(u32x4*)(rp + 3072 + 256 * j + 2 * cb) = pack8(a0, a1); *(u32x4*)(rp + 3072 + 256 * j + 2 * cb + 8) = pack8(b0, b1);
                }
#pragma unroll
            for (int ai = 0; ai < 2; ++ai)
#pragma unroll
                for (int m = 0; m < 4; ++m) { sv[ai][m] += __shfl_xor(sv[ai][m], 16); qv[ai][m] += __shfl_xor(qv[ai][m], 16); }
#pragma unroll
            for (int ai = 0; ai < 2; ++ai)
#pragma unroll
                for (int m = 0; m < 4; ++m) { sv[ai][m] += __shfl_xor(sv[ai][m], 32); qv[ai][m] += __shfl_xor(qv[ai][m], 32); }
            if (fq == 0) {
#pragma unroll
                for (int ai = 0; ai < 2; ++ai)
#pragma unroll
                    for (int m = 0; m < 4; ++m) { float* lp = lnp + ((size_t)(row0 + ai * HALF + m * 16) * 16 + j * 4 + wc) * 2; lp[0] = sv[ai][m]; lp[1] = qv[ai][m]; }
            }
        } else {
#pragma unroll
            for (int ai = 0; ai < 2; ++ai)
#pragma unroll
                for (int m = 0; m < 4; ++m) {
                    const float r = rs[ai][m]; bf16_t* rp = P + (size_t)(row0 + ai * HALF + m * 16) * PW;
                    const f32x4 x0 = acc[ai][0][m][0] * r, x1 = acc[ai][0][m][1] * r, y0 = acc[ai][1][m][0] * r, y1 = acc[ai][1][m][1] * r;
                    f32x4 o0, o1;
                    if (type == 0) { o0 = x0 * y0; o1 = x1 * y1; }
                    else if (type == 1) { o0 = x0 * sigm4(y0); o1 = x1 * sigm4(y1); }
                    else { o0 = gelu4(x0) * sigm4(y0); o1 = gelu4(x1) * sigm4(y1); }
                    *(u32x4*)(rp + type * 1024 + 128 * j + cb) = pack8(o0, o1);
                }
        }
    }
};
struct EpiRes {
    static constexpr int PERM = 2; static constexpr bool AFTER_DRAIN = false;
    bf16_t* X; float* ssx;
    __device__ __forceinline__ void operator()(const f32x4 (&acc)[2][2][4][2], const Unit& u, int wr, int wc, int fr, int fq) const {
        const int row0 = u.pm * BM + wr * 64 + fr, col0 = u.pn * BM + wc * 64 + 16 * fq;
        float qv[2][4];
        bf16_t* p = X + (size_t)row0 * DM + col0;
        u32x4 c0 = *(const u32x4*)p, c1 = *(const u32x4*)(p + 8);
#pragma unroll
        for (int g = 0; g < 8; ++g) {
            const int ai = g >> 2, m = g & 3;
            bf16_t* pn_ = X + (size_t)(row0 + ((g + 1) >> 2) * HALF + ((g + 1) & 3) * 16) * DM + col0;
            u32x4 n0 = c0, n1 = c1;
            if (g < 7) { n0 = *(const u32x4*)pn_; n1 = *(const u32x4*)(pn_ + 8); }
            __builtin_amdgcn_sched_barrier(0);
            const f32x4 v0 = acc[ai][0][m][0] + (f32x4){bf_lo(c0.x), bf_hi(c0.x), bf_lo(c0.y), bf_hi(c0.y)};
            const f32x4 v1 = acc[ai][0][m][1] + (f32x4){bf_lo(c0.z), bf_hi(c0.z), bf_lo(c0.w), bf_hi(c0.w)};
            const f32x4 v2 = acc[ai][1][m][0] + (f32x4){bf_lo(c1.x), bf_hi(c1.x), bf_lo(c1.y), bf_hi(c1.y)};
            const f32x4 v3 = acc[ai][1][m][1] + (f32x4){bf_lo(c1.z), bf_hi(c1.z), bf_lo(c1.w), bf_hi(c1.w)};
            qv[ai][m] = (hsum4(v0 * v0) + hsum4(v1 * v1)) + (hsum4(v2 * v2) + hsum4(v3 * v3));
            *(u32x4*)p = pack8(v0, v1); *(u32x4*)(p + 8) = pack8(v2, v3);
            p = pn_; c0 = n0; c1 = n1;
        }
#pragma unroll
        for (int ai = 0; ai < 2; ++ai)
#pragma unroll
            for (int m = 0; m < 4; ++m) qv[ai][m] += __shfl_xor(qv[ai][m], 16);
#pragma unroll
        for (int ai = 0; ai < 2; ++ai)
#pragma unroll
            for (int m = 0; m < 4; ++m) qv[ai][m] += __shfl_xor(qv[ai][m], 32);
        if (fq == 0) {
#pragma unroll
            for (int ai = 0; ai < 2; ++ai)
#pragma unroll
                for (int m = 0; m < 4; ++m) ssx[(size_t)(row0 + ai * HALF + m * 16) * 16 + u.pn * 4 + wc] = qv[ai][m];
        }
    }
};
struct EpiFF1 {
    static constexpr int PERM = 2; static constexpr bool AFTER_DRAIN = false;
    bf16_t* H; const float* ssx;
    __device__ __forceinline__ void operator()(const f32x4 (&acc)[2][2][4][2], const Unit& u, int wr, int wc, int fr, int fq) const {
        const int row0 = u.pm * BM + wr * 64 + fr, col0 = u.pn * BM + wc * 64 + 16 * fq;
        float rs[2][4]; rows_rstd(rs, ssx, row0, fq);
#pragma unroll
        for (int ai = 0; ai < 2; ++ai)
#pragma unroll
            for (int m = 0; m < 4; ++m) {
                const float r = rs[ai][m]; bf16_t* hp = H + (size_t)(row0 + ai * HALF + m * 16) * 4096 + col0;
#pragma unroll
                for (int bj = 0; bj < 2; ++bj) {
                    f32x4 v0 = acc[ai][bj][m][0] * r, v1 = acc[ai][bj][m][1] * r;
                    v0 = __builtin_elementwise_max(v0, (f32x4){0.f, 0.f, 0.f, 0.f}); v1 = __builtin_elementwise_max(v1, (f32x4){0.f, 0.f, 0.f, 0.f});
                    *(u32x4*)(hp + bj * 8) = pack8(v0 * v0, v1 * v1);
                }
            }
    }
};
template <class Epi, class Sched, bool ALIGN_EPI = false, bool SP2 = false>
__device__ __forceinline__ void gemm_phase(PG8_LAS unsigned char* lds, const GemmL g, const Sched& S, const Epi& E) {
    int tid_ = threadIdx.x; asm volatile("" : "+v"(tid_));
    const int tid = tid_, wid = __builtin_amdgcn_readfirstlane(tid >> 6), lane = tid & 63, wr = wid >> 2, wc = wid & 3, fr = lane & 15, fq = lane >> 4;
    const int K = g.K, nt = K / BK, lda = g.lda;
    unsigned voffA[2], voffB[2];
#pragma unroll
    for (int i = 0; i < 2; ++i) { int R, C; stage_rc(tid * 16 + i * 8192, R, C); const int Rb = Epi::PERM == 2 ? (64 * (R >> 5) + 16 * ((R >> 2) & 3) + 4 * ((R >> 4) & 1) + (R & 3)) : Epi::PERM ? ((R & ~31) + perm32(R & 31)) : R;
        voffA[i] = (unsigned)(R * lda + C) * 2u; voffB[i] = (unsigned)(Rb * K + C) * 2u; }
    const size_t kstep = (size_t)(BK * 2);
    const size_t hstepA = (size_t)HALF * lda * 2, hstepB = Epi::PERM == 2 ? (size_t)8 * K * 2 : (size_t)HALF * K * 2;
    const size_t tstepA = 2 * hstepA, tstepB = (size_t)BM * K * 2;
    const unsigned ldsw = (unsigned)wid * 1024u;
    const int aoff = lds_byte(wr * 64 + fr, fq * 8), boff = lds_byte(wc * 32 + fr, fq * 8);
#define PG8_SA(b, h) (((b) * 2 + (h)) * HTB)
#define PG8_SB(b, h) ((4 + (b) * 2 + (h)) * HTB)
#define PG8_STAGE(bufoff, gbase, voff) do { _Pragma("unroll") for (int _i = 0; _i < 2; ++_i) \
        __builtin_amdgcn_global_load_lds((const unsigned*)((const char*)(gbase) + (voff)[_i]), (PG8_LAS unsigned*)(lds + (bufoff) + ldsw + _i * 8192), 16, 0, 0); } while (0)
#define PG8_LDA(dst, b, h) do { _Pragma("unroll") for (int m = 0; m < 4; ++m) _Pragma("unroll") for (int k = 0; k < 2; ++k) dst[m][k] = *(const PG8_LAS bf16x8*)(lds + PG8_SA(b, h) + aoff + m * 2048 + k * 1024); } while (0)
#define PG8_LDB(dst, b, h) do { _Pragma("unroll") for (int n = 0; n < 2; ++n) _Pragma("unroll") for (int k = 0; k < 2; ++k) dst[n][k] = *(const PG8_LAS bf16x8*)(lds + PG8_SB(b, h) + boff + n * 2048 + k * 1024); } while (0)
#define PG8_MMA(ai, bj, At, Bt) do { __builtin_amdgcn_s_setprio(1); _Pragma("unroll") for (int m = 0; m < 4; ++m) _Pragma("unroll") for (int n = 0; n < 2; ++n) _Pragma("unroll") for (int k = 0; k < 2; ++k) \
        acc[ai][bj][m][n] = __builtin_amdgcn_mfma_f32_16x16x32_bf16(Bt[n][k], At[m][k], acc[ai][bj][m][n], 0, 0, 0); __builtin_amdgcn_s_setprio(0); } while (0)
#define PG8_WAIT_V(n) asm volatile("s_waitcnt vmcnt(" #n ")" ::: "memory")
#define PG8_WAIT_L(n) asm volatile("s_waitcnt lgkmcnt(" #n ")" ::: "memory")
#define PG8_BAR __builtin_amdgcn_s_barrier()
#define PG8_SCHED __builtin_amdgcn_sched_barrier(0)
    Unit cur, nxt; int ui = 0;
    if (!S.next(0, cur)) return;
    f32x4 acc[2][2][4][2];
#pragma unroll
    for (int a = 0; a < 2; ++a)
#pragma unroll
        for (int b = 0; b < 2; ++b)
#pragma unroll
            for (int m = 0; m < 4; ++m)
#pragma unroll
                for (int n = 0; n < 2; ++n) acc[a][b][m][n] = (f32x4){0.f, 0.f, 0.f, 0.f};
    bf16x8 At[4][2], B0[2][2], B1[2][2];
    const char* cA = (const char*)g.A + (size_t)cur.pm * tstepA; const char* cB = (const char*)g.Bt + (size_t)cur.pn * tstepB;
    S.a_ready(cur);
    if constexpr (SP2) {
        PG8_STAGE(PG8_SB(0, 0), cB, voffB); PG8_STAGE(PG8_SB(0, 1), cB + hstepB, voffB); PG8_STAGE(PG8_SA(0, 0), cA, voffA); PG8_STAGE(PG8_SA(0, 1), cA + hstepA, voffA);
        if (wr == 1) PG8_BAR;
        PG8_WAIT_V(2); PG8_BAR;
        PG8_STAGE(PG8_SB(1, 0), cB + kstep, voffB); PG8_STAGE(PG8_SA(1, 0), cA + kstep, voffA); PG8_STAGE(PG8_SB(1, 1), cB + hstepB + kstep, voffB);
        PG8_WAIT_V(6); PG8_BAR;
    } else {
        PG8_STAGE(PG8_SB(0, 0), cB, voffB); PG8_STAGE(PG8_SA(0, 0), cA, voffA); PG8_STAGE(PG8_SB(0, 1), cB + hstepB, voffB); PG8_STAGE(PG8_SA(0, 1), cA + hstepA, voffA);
        if (wr == 1) PG8_BAR;
        PG8_WAIT_V(4); PG8_BAR;
        PG8_STAGE(PG8_SB(1, 0), cB + kstep, voffB); PG8_STAGE(PG8_SA(1, 0), cA + kstep, voffA); PG8_STAGE(PG8_SB(1, 1), cB + hstepB + kstep, voffB);
        PG8_WAIT_V(6); PG8_BAR;
    }
    for (;;) {
        const bool has_next = S.next(ui + 1, nxt);
        const char* nA = has_next ? (const char*)g.A + (size_t)nxt.pm * tstepA : cA; const char* nB = has_next ? (const char*)g.Bt + (size_t)nxt.pn * tstepB : cB;
        for (int t = 0; t < nt; t += 2) {
            const bool last = (t == nt - 2);
            const char* a1 = cA + (size_t)(t + 1) * kstep;
            const char* a2 = last ? nA : cA + (size_t)(t + 2) * kstep; const char* b2 = last ? nB : cB + (size_t)(t + 2) * kstep;
            const char* a3 = a2 + kstep; const char* b3 = b2 + kstep;
            if (last && has_next) S.a_ready(nxt);
            if constexpr (SP2) {
            PG8_LDB(B0, 0, 0); PG8_LDB(B1, 0, 1); PG8_SCHED; PG8_LDA(At, 0, 0); PG8_STAGE(PG8_SA(1, 1), a1 + hstepA, voffA);
            PG8_WAIT_V(8); PG8_WAIT_L(0); PG8_BAR; PG8_MMA(0, 0, At, B0); PG8_MMA(0, 1, At, B1); PG8_BAR; PG8_SCHED;
            PG8_LDA(At, 0, 1); PG8_STAGE(PG8_SB(0, 0), b2, voffB); PG8_STAGE(PG8_SB(0, 1), b2 + hstepB, voffB); PG8_STAGE(PG8_SA(0, 0), a2, voffA);
            PG8_WAIT_V(8); PG8_WAIT_L(0); PG8_BAR; PG8_MMA(1, 0, At, B0); PG8_MMA(1, 1, At, B1); PG8_BAR; PG8_SCHED;
            PG8_LDB(B0, 1, 0); PG8_LDB(B1, 1, 1); PG8_SCHED; PG8_LDA(At, 1, 0); PG8_STAGE(PG8_SA(0, 1), a2 + hstepA, voffA);
            PG8_WAIT_V(8); PG8_WAIT_L(0); PG8_BAR; PG8_MMA(0, 0, At, B0); PG8_MMA(0, 1, At, B1); PG8_BAR; PG8_SCHED;
            PG8_LDA(At, 1, 1); PG8_STAGE(PG8_SB(1, 0), b3, voffB); PG8_STAGE(PG8_SB(1, 1), b3 + hstepB, voffB); PG8_STAGE(PG8_SA(1, 0), a3, voffA);
            PG8_WAIT_V(8); PG8_WAIT_L(0); PG8_BAR; PG8_MMA(1, 0, At, B0); PG8_MMA(1, 1, At, B1); PG8_BAR; PG8_SCHED;
            } else {
            PG8_LDB(B0, 0, 0); PG8_SCHED; PG8_LDA(At, 0, 0); PG8_STAGE(PG8_SA(1, 1), a1 + hstepA, voffA);
            PG8_WAIT_L(8); PG8_BAR; PG8_WAIT_L(0); PG8_MMA(0, 0, At, B0); PG8_BAR; PG8_SCHED;
            PG8_LDB(B1, 0, 1); PG8_STAGE(PG8_SB(0, 0), b2, voffB);
            PG8_BAR; PG8_WAIT_L(0); PG8_MMA(0, 1, At, B1); PG8_BAR;
            PG8_LDA(At, 0, 1); PG8_STAGE(PG8_SA(0, 0), a2, voffA);
            PG8_BAR; PG8_WAIT_L(0); PG8_MMA(1, 0, At, B0); PG8_BAR; PG8_SCHED;
            PG8_STAGE(PG8_SB(0, 1), b2 + hstepB, voffB);
            PG8_WAIT_V(6); PG8_BAR; PG8_MMA(1, 1, At, B1); PG8_BAR;
            PG8_LDB(B0, 1, 0); PG8_SCHED; PG8_LDA(At, 1, 0); PG8_STAGE(PG8_SA(0, 1), a2 + hstepA, voffA);
            PG8_WAIT_L(8); PG8_BAR; PG8_WAIT_L(0); PG8_MMA(0, 0, At, B0); PG8_BAR; PG8_SCHED;
            PG8_LDB(B1, 1, 1); PG8_STAGE(PG8_SB(1, 0), b3, voffB);
            PG8_BAR; PG8_WAIT_L(0); PG8_MMA(0, 1, At, B1); PG8_BAR;
            PG8_LDA(At, 1, 1); PG8_STAGE(PG8_SA(1, 0), a3, voffA);
            PG8_BAR; PG8_WAIT_L(0); PG8_MMA(1, 0, At, B0); PG8_BAR; PG8_SCHED;
            PG8_STAGE(PG8_SB(1, 1), b3 + hstepB, voffB);
            PG8_WAIT_V(6); PG8_BAR; PG8_MMA(1, 1, At, B1); PG8_BAR;
            }
        }
        if constexpr (ALIGN_EPI) { if (wr == 0) PG8_BAR; }
        if constexpr (!Epi::AFTER_DRAIN) { E(acc, cur, wr, wc, fr, fq); S.done(cur); }
        if (!has_next) break;
#pragma unroll
        for (int a = 0; a < 2; ++a)
#pragma unroll
            for (int b = 0; b < 2; ++b)
#pragma unroll
                for (int m = 0; m < 4; ++m)
#pragma unroll
                    for (int n = 0; n < 2; ++n) acc[a][b][m][n] = (f32x4){0.f, 0.f, 0.f, 0.f};
        cur = nxt; cA = nA; cB = nB; ++ui;
        if constexpr (ALIGN_EPI) { if (wr == 1) PG8_BAR; }
    }
    PG8_WAIT_V(0);
    if constexpr (!ALIGN_EPI) { if (wr == 0) PG8_BAR; }
    PG8_BAR;
    if constexpr (Epi::AFTER_DRAIN) { E.fused(acc, cur, wr, wc, fr, fq, lds, wid, lane); S.done(cur); }
#undef PG8_SA
#undef PG8_SB
#undef PG8_STAGE
#undef PG8_LDA
#undef PG8_LDB
#undef PG8_MMA
#undef PG8_WAIT_V
#undef PG8_WAIT_L
#undef PG8_BAR
#undef PG8_SCHED
}
}
using pg8::bf16_t; using pg8::bf16x8; using pg8::f32x4; using pg8::u32x4;
#define LAS __attribute__((address_space(3)))
typedef float f32x2 __attribute__((ext_vector_type(2)));
typedef unsigned u32x2 __attribute__((ext_vector_type(2)));
#define LDS_WAIT() asm volatile("s_waitcnt lgkmcnt(0)" ::: "memory")

constexpr int BATCH = 8, SEQ = 4096, D = 1024, NIN = 7168, FF = 4096, DEPTH = 4, CHUNK = 128, NH = 8;
constexpr int M = BATCH * SEQ;
constexpr int NWAVES = 8, NTHR = 512;
constexpr size_t MiB = 1u << 20;
constexpr size_t WS_WIN = 0;
constexpr size_t WS_WOUT = 56 * MiB;
constexpr size_t WS_W1 = 64 * MiB;
constexpr size_t WS_W2 = 96 * MiB;
constexpr size_t WS_SGU = 128 * MiB;
constexpr size_t WS_SSX = 129 * MiB;
constexpr size_t WS_LNP = 131 * MiB;
constexpr size_t WS_XB = 136 * MiB;
constexpr size_t WS_P = 200 * MiB;
constexpr size_t WS_CTL = 456 * MiB, CTL_BYTES = 65536;
constexpr size_t WS_END = 457 * MiB;
constexpr int LDS_XB = 141312;
constexpr int LDS_BYTES = 142336;

__device__ __forceinline__ float wave_sum(float v) {
#pragma unroll
    for (int o = 1; o < 64; o <<= 1) v += __shfl_xor(v, o);
    return v;
}
__device__ __forceinline__ int inv_map_in(int src) {
    const int sec = src >> 10, ch = src & 1023;
    if (sec == 4) return 6144 + ch;
    const int type = (sec == 0 || sec == 2) ? 0 : (sec == 1 || sec == 5) ? 1 : 2, half = (sec == 2 || sec == 5 || sec == 6) ? 1 : 0;
    const int j = ch >> 7, r = ch & 127;
    return type * 2048 + 256 * j + 16 * (r >> 3) + 8 * half + (r & 7);
}
template <bool MAP, bool SCALE> __device__ __forceinline__ void transpose_item(const float* W, int N, int n0src, const float* gk, bf16_t* WT, int K, int n0dst, int k0, LAS float* scr, int lane) {
#pragma unroll
    for (int i = 0; i < 32; ++i) { const int kk = 2 * i + (lane >> 5); scr[kk * 33 + (lane & 31)] = W[(size_t)(k0 + kk) * N + n0src + (lane & 31)]; }
    LDS_WAIT(); asm volatile("" ::: "memory");
    const int c = lane & 7;
    f32x4 ga = (f32x4){1.f, 1.f, 1.f, 1.f}, gb = ga;
    if (SCALE) { ga = *(const f32x4*)(gk + k0 + 8 * c); gb = *(const f32x4*)(gk + k0 + 8 * c + 4); }
#pragma unroll
    for (int jj = 0; jj < 4; ++jj) { const int n = (lane >> 3) + 8 * jj; const LAS float* s = scr + (8 * c) * 33 + n;
        u32x4 o; o.x = pg8::cvt_pk_bf16(s[0 * 33] * ga[0], s[1 * 33] * ga[1]); o.y = pg8::cvt_pk_bf16(s[2 * 33] * ga[2], s[3 * 33] * ga[3]); o.z = pg8::cvt_pk_bf16(s[4 * 33] * gb[0], s[5 * 33] * gb[1]); o.w = pg8::cvt_pk_bf16(s[6 * 33] * gb[2], s[7 * 33] * gb[3]);
        *(u32x4*)(WT + (size_t)(MAP ? inv_map_in(n0src + n) : n0dst + n) * K + k0 + 8 * c) = o; }
    LDS_WAIT(); asm volatile("" ::: "memory");
}

struct Args { const float* in[13]; float* out; unsigned char* ws; };

__device__ __forceinline__ void p0_prologue(const Args& a, LAS unsigned char* lds) {
    const int tid = threadIdx.x, lane = tid & 63, wave = __builtin_amdgcn_readfirstlane(tid >> 6);
    const int gw = blockIdx.x * NWAVES + wave, NGW = gridDim.x * NWAVES;
    LAS float* scr = (LAS float*)(lds + wave * 16384);
    const float* norm_mix = a.in[1]; const float* w_in = a.in[2]; const float* w_out = a.in[8]; const float* norm_mlp = a.in[9]; const float* w_ff1 = a.in[10]; const float* w_ff2 = a.in[11];
    bf16_t* WIN = (bf16_t*)(a.ws + WS_WIN); bf16_t* WOUT = (bf16_t*)(a.ws + WS_WOUT); bf16_t* W1 = (bf16_t*)(a.ws + WS_W1); bf16_t* W2 = (bf16_t*)(a.ws + WS_W2);
    constexpr int I_IN = 16 * (NIN / 32), I_OUT = 16 * (D / 32), I_1 = 16 * (FF / 32), I_2 = (FF / 64) * (D / 32), I_L = I_IN + I_OUT + I_1 + I_2;
    for (int it = gw; it < DEPTH * I_L; it += NGW) {
        const int l = it / I_L; int r = it % I_L;
        if (r < I_IN) { const int kb = r / (NIN / 32), nb = r % (NIN / 32); transpose_item<true, true>(w_in + (size_t)l * D * NIN, NIN, 32 * nb, norm_mix + l * D, WIN + (size_t)l * NIN * D, D, 32 * nb, 64 * kb, scr, lane); continue; } r -= I_IN;
        if (r < I_OUT) { const int kb = r / (D / 32), nb = r % (D / 32); transpose_item<false, false>(w_out + (size_t)l * D * D, D, 32 * nb, nullptr, WOUT + (size_t)l * D * D, D, 32 * nb, 64 * kb, scr, lane); continue; } r -= I_OUT;
        if (r < I_1) { const int kb = r / (FF / 32), nb = r % (FF / 32); transpose_item<false, true>(w_ff1 + (size_t)l * D * FF, FF, 32 * nb, norm_mlp + l * D, W1 + (size_t)l * FF * D, D, 32 * nb, 64 * kb, scr, lane); continue; } r -= I_1;
        { const int kb = r / (D / 32), nb = r % (D / 32); transpose_item<false, false>(w_ff2 + (size_t)l * FF * D, D, 32 * nb, nullptr, W2 + (size_t)l * D * FF, FF, 32 * nb, 64 * kb, scr, lane); }
    }
    const float* x = a.in[0]; bf16_t* XB = (bf16_t*)(a.ws + WS_XB); float* ssx = (float*)(a.ws + WS_SSX);
    for (int m = gw; m < M; m += NGW) {
        const f32x4* xr = (const f32x4*)(x + (size_t)m * D) + lane; float s = 0.f; f32x4 v[4];
#pragma unroll
        for (int j = 0; j < 4; ++j) { v[j] = xr[64 * j]; s += pg8::hsum4(v[j] * v[j]); }
        s = wave_sum(s);
        u32x2* o = (u32x2*)(XB + (size_t)m * D) + lane;
#pragma unroll
        for (int j = 0; j < 4; ++j) { u32x2 w; w.x = pg8::cvt_pk_bf16(v[j][0], v[j][1]); w.y = pg8::cvt_pk_bf16(v[j][2], v[j][3]); o[64 * j] = w; }
        if (lane < 16) ssx[(size_t)m * 16 + lane] = lane == 0 ? s : 0.f;
    }
    const float* sw = a.in[4]; bf16_t* SG = (bf16_t*)(a.ws + WS_SGU);
    for (int e = blockIdx.x * NTHR + tid; e < DEPTH * NH * CHUNK * CHUNK / 4; e += gridDim.x * NTHR) {
        const f32x4 v = *((const f32x4*)sw + e); const int s0 = (e * 4) & 127, t = ((e * 4) >> 7) & 127;
        u32x2 w; w.x = pg8::cvt_pk_bf16(s0 <= t ? v[0] : 0.f, s0 + 1 <= t ? v[1] : 0.f); w.y = pg8::cvt_pk_bf16(s0 + 2 <= t ? v[2] : 0.f, s0 + 3 <= t ? v[3] : 0.f);
        *((u32x2*)SG + e) = w;
    }
}

constexpr int VN_STRIDE = 272;
constexpr int MX_STRIDE = 132;
constexpr int LDS_VN = 0, LDS_MX = 128 * VN_STRIDE, LDS_ST = LDS_MX + 128 * MX_STRIDE * 4;
constexpr int LDS_WS = LDS_ST + 1024;
constexpr int LDS_CT = LDS_WS + 128 * VN_STRIDE;
static_assert(LDS_CT + 16 * 160 <= LDS_XB, "mixer LDS map");
#define MIX_BAR() do { asm volatile("s_waitcnt lgkmcnt(0)" ::: "memory"); __builtin_amdgcn_s_barrier(); asm volatile("" ::: "memory"); } while (0)
#define UNP0(r) ((f32x4){pg8::bf_lo(r.x), pg8::bf_hi(r.x), pg8::bf_lo(r.y), pg8::bf_hi(r.y)})
#define UNP1(r) ((f32x4){pg8::bf_lo(r.z), pg8::bf_hi(r.z), pg8::bf_lo(r.w), pg8::bf_hi(r.w)})
__device__ __forceinline__ void mixer_phase(LAS unsigned char* lds, bf16_t* P, const float* lnp, const float* lng, const float* lnb, const bf16_t* Wsb, const float* bs, const float* cw, int rank, int nloc, int xi, int nx) {
    int tid_ = threadIdx.x; asm volatile("" : "+v"(tid_));
    const int tid = tid_, lane = tid & 63, w = __builtin_amdgcn_readfirstlane(tid >> 6), fr = lane & 15, fq = lane >> 4;
    const int dc = tid & 15, sr = tid >> 4;
    LAS f32x2* ST = (LAS f32x2*)(lds + LDS_ST);
    const LAS f32x4* CT = (const LAS f32x4*)(lds + LDS_CT + dc * 160);
#define MIX_DECODE(i_, valid_, h_, cn_) do { const int U_ = (i_) * nloc + rank, b_ = xi + (U_ >> 8) * nx; valid_ = b_ < 8; h_ = U_ & 7; cn_ = b_ * 32 + ((U_ & 255) >> 3); } while (0)
    float bsv[8];
    u32x4 nraw[4]; f32x4 nst[2];
    int it = 0, cur_h = -1; bool valid; int h, cn;
    MIX_DECODE(0, valid, h, cn);
    if (valid) {
        const int d0n = h * 128 + 8 * dc;
#pragma unroll
        for (int j = 0; j < 4; ++j) nraw[j] = *(const u32x4*)(P + (size_t)(cn * CHUNK + sr + 32 * j) * pg8::PW + 3072 + d0n);
        const f32x4* p = (const f32x4*)(lnp + (size_t)(cn * CHUNK + (tid >> 2)) * 32 + 8 * (tid & 3)); nst[0] = p[0]; nst[1] = p[1];
    }
    while (valid) {
        const int row0 = cn * CHUNK, d0 = h * 128 + 8 * dc;
        if (h != cur_h) {
            MIX_BAR();
#pragma unroll
            for (int i = 0; i < 8; ++i) bsv[i] = bs[h * 128 + 16 * i + fr];
            u32x4 wt[4];
#pragma unroll
            for (int j = 0; j < 4; ++j) wt[j] = *(const u32x4*)(Wsb + (size_t)(h * 128 + sr + 32 * j) * 128 + 8 * dc);
#pragma unroll
            for (int j = 0; j < 4; ++j) *(LAS u32x4*)(lds + LDS_WS + (sr + 32 * j) * VN_STRIDE + dc * 16) = wt[j];
            if (tid < 160) {
                const int tdc = tid / 10, k = tid % 10, td0 = h * 128 + 8 * tdc + 4 * (k & 1);
                const float* src = k < 2 ? lng + td0 : k < 4 ? lnb + td0 : cw + (k / 2 - 2) * 1024 + td0;
                *(LAS f32x4*)(lds + LDS_CT + tdc * 160 + k * 16) = *(const f32x4*)src;
            }
            cur_h = h;
        }
        u32x4 pc0[4], pc1[4], pc2[4], pbg[4], pug[4];
#pragma unroll
        for (int j = 0; j < 4; ++j) {
            const int t = sr + 32 * j, pos = (cn & 31) * CHUNK + t; const bf16_t* rp = P + (size_t)(row0 + t) * pg8::PW + d0;
            pc0[j] = *(const u32x4*)rp; pc1[j] = *(const u32x4*)(rp - (pos >= 1 ? pg8::PW : 0)); pc2[j] = *(const u32x4*)(rp - (pos >= 2 ? 2 * pg8::PW : 0));
            pbg[j] = *(const u32x4*)(rp + 1024); pug[j] = *(const u32x4*)(rp + 2048);
        }
        {
            float s = (nst[0][0] + nst[0][2]) + (nst[1][0] + nst[1][2]), q = (nst[0][1] + nst[0][3]) + (nst[1][1] + nst[1][3]);
            s += __shfl_xor(s, 1); s += __shfl_xor(s, 2); q += __shfl_xor(q, 1); q += __shfl_xor(q, 2);
            const float mean = s * (1.0f / D), var = fmaxf(q * (1.0f / D) - mean * mean, 0.f);
            if ((tid & 3) == 0) ST[tid >> 2] = (f32x2){mean, rsqrtf(var + pg8::EPS)};
        }
        MIX_BAR();
        {
            const f32x4 g0 = CT[0], g1 = CT[1], b0 = CT[2], b1 = CT[3];
            f32x2 st[4];
#pragma unroll
            for (int j = 0; j < 4; ++j) st[j] = ST[sr + 32 * j];
#pragma unroll
            for (int j = 0; j < 4; ++j) {
                const f32x4 v0 = (UNP0(nraw[j]) - st[j].x) * st[j].y * g0 + b0, v1 = (UNP1(nraw[j]) - st[j].x) * st[j].y * g1 + b1;
                *(LAS u32x4*)(lds + LDS_VN + (sr + 32 * j) * VN_STRIDE + dc * 16) = pg8::pack8(v0, v1);
            }
        }
        MIX_BAR();
        bool nvalid; int nh, ncn;
        MIX_DECODE(it + 1, nvalid, nh, ncn);
        {
            const int pcn = nvalid ? ncn : cn, ph = nvalid ? nh : h, nr0 = pcn * CHUNK, d0n = ph * 128 + 8 * dc;
#pragma unroll
            for (int j = 0; j < 4; ++j) nraw[j] = *(const u32x4*)(P + (size_t)(nr0 + sr + 32 * j) * pg8::PW + 3072 + d0n);
            const f32x4* p = (const f32x4*)(lnp + (size_t)(nr0 + (tid >> 2)) * 32 + 8 * (tid & 3)); nst[0] = p[0]; nst[1] = p[1];
        }
        {
            bf16x8 av[4];
#pragma unroll
            for (int kk = 0; kk < 4; ++kk)
#pragma unroll
                for (int e = 0; e < 8; ++e) av[kk][e] = *(const LAS short*)(lds + LDS_VN + (32 * kk + 8 * fq + e) * VN_STRIDE + (16 * w + fr) * 2);
#pragma unroll
            for (int i = 0; i < 8; ++i) {
                f32x4 acc = (f32x4){0.f, 0.f, 0.f, 0.f};
#pragma unroll
                for (int kk = 0; kk < 4; ++kk) if (kk <= i / 2) acc = __builtin_amdgcn_mfma_f32_16x16x32_bf16(av[kk], *(const LAS bf16x8*)(lds + LDS_WS + (16 * i + fr) * VN_STRIDE + (32 * kk + 8 * fq) * 2), acc, 0, 0, 0);
                acc = acc + bsv[i];
                *(LAS f32x4*)(lds + LDS_MX + ((16 * i + fr) * MX_STRIDE + 16 * w + 4 * fq) * 4) = acc;
            }
        }
        MIX_BAR();
        {
            const f32x4 w00 = CT[4], w01 = CT[5], w10 = CT[6], w11 = CT[7], w20 = CT[8], w21 = CT[9];
            const u32x4 zero = (u32x4){0u, 0u, 0u, 0u};
#pragma unroll
            for (int j = 0; j < 4; ++j) {
                const int t = sr + 32 * j, pos = (cn & 31) * CHUNK + t; bf16_t* rp = P + (size_t)(row0 + t) * pg8::PW + d0;
                const LAS f32x4* mx = (const LAS f32x4*)(lds + LDS_MX + (t * MX_STRIDE + 8 * dc) * 4);
                const f32x4 m0 = mx[0], m1 = mx[1];
                const u32x4 c1 = pos >= 1 ? pc1[j] : zero, c2 = pos >= 2 ? pc2[j] : zero;
                const f32x4 o0 = UNP0(pbg[j]) * (w00 * UNP0(c2) + w10 * UNP0(c1) + w20 * UNP0(pc0[j])) + UNP0(pug[j]) * m0;
                const f32x4 o1 = UNP1(pbg[j]) * (w01 * UNP1(c2) + w11 * UNP1(c1) + w21 * UNP1(pc0[j])) + UNP1(pug[j]) * m1;
                *(u32x4*)(rp + 1024) = pg8::pack8(o0, o1);
            }
        }
        ++it; valid = nvalid; h = nh; cn = ncn;
    }
#undef MIX_DECODE
    asm volatile("s_waitcnt vmcnt(0) lgkmcnt(0)" ::: "memory"); __builtin_amdgcn_s_barrier(); asm volatile("" ::: "memory");
}
#undef UNP0
#undef UNP1

__device__ __forceinline__ void final_phase(const bf16_t* XB, const float* fn, float* out, int rank, int nloc, int xi, int nx) {
    const int tid = threadIdx.x, lane = tid & 63, wave = tid >> 6; const int gw = rank * NWAVES + wave, NGW = nloc * NWAVES;
    f32x4 g[2][2];
#pragma unroll
    for (int j = 0; j < 2; ++j) { g[j][0] = *(const f32x4*)(fn + 8 * lane + 512 * j); g[j][1] = *(const f32x4*)(fn + 8 * lane + 512 * j + 4); }
    for (int b = xi; b < BATCH; b += nx)
    for (int m = b * SEQ + gw; m < (b + 1) * SEQ; m += 4 * NGW) {
        u32x4 r[4][2]; int mr[4];
#pragma unroll
        for (int q = 0; q < 4; ++q) { mr[q] = m + q * NGW < (b + 1) * SEQ ? m + q * NGW : m;
#pragma unroll
            for (int j = 0; j < 2; ++j) r[q][j] = *(const u32x4*)(XB + (size_t)mr[q] * D + 8 * lane + 512 * j); }
#pragma unroll
        for (int q = 0; q < 4; ++q) {
            f32x4 v[2][2]; float s = 0.f;
#pragma unroll
            for (int j = 0; j < 2; ++j) { v[j][0] = (f32x4){pg8::bf_lo(r[q][j].x), pg8::bf_hi(r[q][j].x), pg8::bf_lo(r[q][j].y), pg8::bf_hi(r[q][j].y)}; v[j][1] = (f32x4){pg8::bf_lo(r[q][j].z), pg8::bf_hi(r[q][j].z), pg8::bf_lo(r[q][j].w), pg8::bf_hi(r[q][j].w)};
                s += pg8::hsum4(v[j][0] * v[j][0]) + pg8::hsum4(v[j][1] * v[j][1]); }
            const float rs = rsqrtf(wave_sum(s) * (1.0f / D) + pg8::EPS);
            if (q == 0 || mr[q] != m) {
#pragma unroll
                for (int j = 0; j < 2; ++j) { f32x4* o = (f32x4*)(out + (size_t)mr[q] * D + 8 * lane + 512 * j); o[0] = v[j][0] * rs * g[j][0]; o[1] = v[j][1] * rs * g[j][1]; }
            }
        }
    }
}

#define XC_CNT(j) (64 * (j))
#define XC_ARR(j) (1024 + 64 * (j))
#define XC_GEN(j) (2048 + 64 * (j))
#define XC_TMO    3072
__device__ __forceinline__ unsigned xb_ld(unsigned* p)              { return __hip_atomic_load(p, __ATOMIC_RELAXED, __HIP_MEMORY_SCOPE_AGENT); }
__device__ __forceinline__ unsigned xb_add(unsigned* p, unsigned v) { return __hip_atomic_fetch_add(p, v, __ATOMIC_RELAXED, __HIP_MEMORY_SCOPE_AGENT); }
__device__ __forceinline__ unsigned xb_xcc_id() { return (unsigned)__builtin_amdgcn_s_getreg((3 << 11) | 20) & 0xFu; }
__device__ __forceinline__ void xcd_local_barrier(unsigned* ctl, unsigned x, unsigned nloc) {
    asm volatile("s_waitcnt vmcnt(0)" ::: "memory");
    __syncthreads();
    if (threadIdx.x == 0) {
        __builtin_amdgcn_s_waitcnt(0);
        const unsigned old = xb_add(&ctl[XC_ARR(x)], 1u), gen = old / nloc;
        if (old + 1u == (gen + 1u) * nloc) {
            __builtin_amdgcn_fence(__ATOMIC_RELEASE, "agent");
            asm volatile("s_waitcnt vmcnt(0)" ::: "memory");
            xb_add(&ctl[XC_GEN(x)], 1u);
        } else {
            unsigned sp = 0;
            while (xb_ld(&ctl[XC_GEN(x)]) == gen) { __builtin_amdgcn_s_sleep(1); if ((++sp & 255u) == 0u) { if (xb_ld(&ctl[XC_TMO])) break; if (sp > (1u << 20)) { atomicAdd(&ctl[XC_TMO], 1u); break; } } }
        }
        __builtin_amdgcn_fence(__ATOMIC_ACQUIRE, "agent");
        asm volatile("s_waitcnt vmcnt(0)" ::: "memory");
    }
    __syncthreads();
}

__global__ void __launch_bounds__(NTHR, 2) fwd_megakernel(Args a) {
    extern __shared__ __attribute__((aligned(16))) unsigned char lds_raw[];
    LAS unsigned char* lds = (LAS unsigned char*)lds_raw;
    cg::grid_group grid = cg::this_grid();
    unsigned char* ws = a.ws;
    bf16_t* XB = (bf16_t*)(ws + WS_XB); bf16_t* P = (bf16_t*)(ws + WS_P); float* ssx = (float*)(ws + WS_SSX); float* lnp = (float*)(ws + WS_LNP);
    unsigned* ctl = (unsigned*)(ws + WS_CTL);
    volatile LAS unsigned* LW = (volatile LAS unsigned*)(lds + LDS_XB);
    if (threadIdx.x == 0) { const unsigned x = xb_xcc_id(); LW[0] = xb_add(&ctl[XC_CNT(x)], 1u); LW[1] = x; }
    __syncthreads();
    const int rank = __builtin_amdgcn_readfirstlane((int)LW[0]), xcc = __builtin_amdgcn_readfirstlane((int)LW[1]);

    p0_prologue(a, lds);
    grid.sync();
    int nloc = 1, xi = 0, nx = 0;
    const int cl = (threadIdx.x & 63) < 16 ? (int)xb_ld(&ctl[XC_CNT(threadIdx.x & 15)]) : 0;
#pragma unroll
    for (int j = 0; j < 16; ++j) { const int cj = __builtin_amdgcn_readlane(cl, j); nx += cj > 0; xi += (cj > 0 && j < xcc); if (j == xcc) nloc = cj; }
#pragma unroll 1
    for (int l = 0; l < DEPTH; ++l) {
        {
            pg8::GemmL g{XB, (const bf16_t*)(ws + WS_WIN) + (size_t)l * NIN * D, M, NIN, D, D}; pg8::XcdOrder S; S.init(NIN, nloc, rank, xi, nx);
            pg8::EpiIn E{P, ssx, lnp};
            pg8::gemm_phase<pg8::EpiIn, pg8::XcdOrder, true, true>(lds, g, S, E);
        }
        xcd_local_barrier(ctl, (unsigned)xcc, (unsigned)nloc);
        mixer_phase(lds, P, lnp, a.in[6] + l * D, a.in[7] + l * D, (const bf16_t*)(ws + WS_SGU) + (size_t)l * NH * CHUNK * CHUNK, a.in[5] + l * NH * CHUNK, a.in[3] + l * 3 * D, rank, nloc, xi, nx);
        xcd_local_barrier(ctl, (unsigned)xcc, (unsigned)nloc);
        {
            pg8::GemmL g{P + 1024, (const bf16_t*)(ws + WS_WOUT) + (size_t)l * D * D, M, D, D, pg8::PW}; pg8::XcdOrder S; S.init(D, nloc, rank, xi, nx);
            pg8::EpiRes E{XB, ssx};
            pg8::gemm_phase<pg8::EpiRes, pg8::XcdOrder, true, true>(lds, g, S, E);
        }
        xcd_local_barrier(ctl, (unsigned)xcc, (unsigned)nloc);
        {
            pg8::GemmL g{XB, (const bf16_t*)(ws + WS_W1) + (size_t)l * FF * D, M, FF, D, D}; pg8::XcdOrder S; S.init(FF, nloc, rank, xi, nx);
            pg8::EpiFF1 E{P, ssx};
            pg8::gemm_phase<pg8::EpiFF1, pg8::XcdOrder, true, true>(lds, g, S, E);
        }
        xcd_local_barrier(ctl, (unsigned)xcc, (unsigned)nloc);
        {
            pg8::GemmL g{P, (const bf16_t*)(ws + WS_W2) + (size_t)l * D * FF, M, D, FF, FF}; pg8::XcdOrder S; S.init(D, nloc, rank, xi, nx);
            pg8::EpiRes E{XB, ssx};
            pg8::gemm_phase<pg8::EpiRes, pg8::XcdOrder, true, true>(lds, g, S, E);
        }
        xcd_local_barrier(ctl, (unsigned)xcc, (unsigned)nloc);
    }
    final_phase(XB, a.in[12], a.out, rank, nloc, xi, nx);
}

extern "C" void kernel_launch(void* const* d_in, const int* in_sizes, int n_in, void* d_out, int out_size, void* d_ws, size_t ws_size, hipStream_t stream) {
    static int grid = 0;
    if (grid == 0) {
        if (n_in != 13 || ws_size < WS_END) { fprintf(stderr, "kernel_launch: unexpected inputs (n_in %d, ws %zu)\n", n_in, ws_size); grid = -1; return; }
        int dev = 0, cus = 0, per_cu = 0;
        hipGetDevice(&dev); hipDeviceGetAttribute(&cus, hipDeviceAttributeMultiprocessorCount, dev);
        hipFuncSetAttribute((const void*)fwd_megakernel, hipFuncAttributeMaxDynamicSharedMemorySize, LDS_BYTES);
        if (hipOccupancyMaxActiveBlocksPerMultiprocessor(&per_cu, (const void*)fwd_megakernel, NTHR, LDS_BYTES) != hipSuccess || per_cu < 1) { fprintf(stderr, "kernel_launch: occupancy query says %d\n", per_cu); per_cu = 1; }
        (void)hipGetLastError();
        grid = cus * per_cu;
    }
    if (grid < 0) return;
    Args a{};
    for (int i = 0; i < 13; ++i) a.in[i] = (const float*)d_in[i];
    a.out = (float*)d_out; a.ws = (unsigned char*)d_ws;
    if (hipMemsetAsync((char*)d_ws + WS_CTL, 0, CTL_BYTES, stream) != hipSuccess) { fprintf(stderr, "memset failed\n"); return; }
    void* args[] = {&a};
    hipError_t e = hipLaunchCooperativeKernel((const void*)fwd_megakernel, dim3(grid), dim3(NTHR), args, LDS_BYTES, stream);
    if (e != hipSuccess) fprintf(stderr, "cooperative launch failed: %s (grid %d)\n", hipGetErrorString(e), grid);
}
```
